# Optimizing an MI355X kernel written in HIP

```python
import math
import jax, jax.numpy as jnp
from jax import lax
import numpy as np

D_MODEL = 1024
BATCH = 4
SEQ = 8192
DEPTH = 4

N_MIXERS = 4
CONV_WIDTH = 3
CONV_DIM = D_MODEL
DIL_WINDOWS = (128, 512, 2048)
DIL_RATES = (1, 4, 16)
DIL_HEADS = 8
DIL_HEAD_DIM = D_MODEL // DIL_HEADS
DIL_DIM = DIL_HEADS * DIL_HEAD_DIM
SWA_HALF = 128
SWA_Q_HEADS = 16
SWA_KV_HEADS = 4
SWA_HEAD_DIM = 64
SWA_DIM = SWA_Q_HEADS * SWA_HEAD_DIM
DIFF_HEADS = 8
DIFF_HEAD_DIM = D_MODEL // (2 * DIFF_HEADS)
DIFF_DIM = DIFF_HEADS * 2 * DIFF_HEAD_DIM
Q_BLOCK = 128

ROPE_THETA = 10000.0
NORM_EPS = 1e-6
SUBLN_EPS = 1e-5
NEG_INF = -1e30

kernel_name = "hybrid_interleaved_bidir_encoder"


def _layers_of_type(t):
    return len(range(t, DEPTH, N_MIXERS))


def rms_norm(x, g, eps):
    xf = x.astype(jnp.float32)
    y = xf * lax.rsqrt(jnp.mean(xf * xf, axis=-1, keepdims=True) + eps)
    return (y * g.astype(jnp.float32)).astype(x.dtype)


def rope_tables(seq, dim):
    inv = ROPE_THETA ** (-jnp.arange(0, dim, 2, dtype=jnp.float32) / dim)
    ang = jnp.arange(seq, dtype=jnp.float32)[:, None] * inv[None, :]
    return jnp.cos(ang), jnp.sin(ang)


def apply_rope(x, cos, sin):
    shp = (cos.shape[0],) + (1,) * (x.ndim - 3) + (cos.shape[1],)
    cos, sin = cos.reshape(shp), sin.reshape(shp)
    x1, x2 = jnp.split(x.astype(jnp.float32), 2, axis=-1)
    return jnp.concatenate([x1 * cos - x2 * sin, x2 * cos + x1 * sin], axis=-1).astype(x.dtype)


def adaln_pre_norm(x, c, g, w_mod, b_mod):
    mod = jax.nn.silu(c) @ w_mod + b_mod
    shift, scale, gate = jnp.split(mod, 3, axis=-1)
    h = rms_norm(x, g, NORM_EPS) * (1.0 + scale[:, None, :]) + shift[:, None, :]
    return h, gate


def banded_attention(q, k, v, half, sink=None):
    N, L, Hk, G, D = q.shape
    Dv = v.shape[-1]
    blk = half
    nb = -(-L // blk)
    Lp = nb * blk
    qp = jnp.pad(q, ((0, 0), (0, Lp - L), (0, 0), (0, 0), (0, 0))).reshape(N, nb, blk, Hk, G, D)
    kv_pad = ((0, 0), (blk, Lp - L + blk), (0, 0), (0, 0))
    kp = jnp.pad(k, kv_pad).reshape(N, nb + 2, blk, Hk, D)
    vp = jnp.pad(v, kv_pad).reshape(N, nb + 2, blk, Hk, Dv)
    band = lambda t: jnp.concatenate([t[:, :-2], t[:, 1:-1], t[:, 2:]], axis=2)
    kw, vw = band(kp), band(vp)
    qpos = jnp.arange(Lp).reshape(nb, blk)
    kpos = (jnp.arange(nb)[:, None] - 1) * blk + jnp.arange(3 * blk)[None, :]
    kk = kpos[:, None, :]
    valid = (jnp.abs(kk - qpos[:, :, None]) <= half) & (kk >= 0) & (kk < L)
    scale = D ** -0.5
    sink_f = None if sink is None else sink.astype(jnp.float32)[None, :, :, None]

    def one(args):
        qs, ks, vs = args
        s = jnp.einsum('bqhgd,bkhd->bhgqk', qs, ks, preferred_element_type=jnp.float32) * scale
        s = jnp.where(valid[:, None, None], s, NEG_INF)
        m = jnp.max(s, axis=-1)
        if sink_f is not None:
            m = jnp.maximum(m, sink_f)
        p = jnp.exp(s - m[..., None])
        l = jnp.sum(p, axis=-1)
        if sink_f is not None:
            l = l + jnp.exp(sink_f - m)
        o = jnp.einsum('bhgqk,bkhe->bqhge', p, vs.astype(jnp.float32))
        l_t = jnp.moveaxis(l, -1, 1)
        return o / l_t[..., None], jnp.moveaxis(m, -1, 1) + jnp.log(l_t)

    o, lse = lax.map(one, (qp, kw, vw))
    o = o.reshape(N, Lp, Hk, G, Dv)[:, :L]
    lse = lse.reshape(N, Lp, Hk, G)[:, :L]
    return o, lse


def to_strided(x, r):
    B, S = x.shape[:2]
    rest = x.shape[2:]
    x = x.reshape((B, S // r, r) + rest)
    return jnp.moveaxis(x, 2, 1).reshape((B * r, S // r) + rest)


def from_strided(x, r, B):
    L = x.shape[1]
    rest = x.shape[2:]
    x = x.reshape((B, r, L) + rest)
    return jnp.moveaxis(x, 1, 2).reshape((B, L * r) + rest)


def short_conv_mixer(h, w_in, conv_k, w_out):
    b_gate, c_gate, xin, z = jnp.split(h @ w_in, 4, axis=-1)
    t = c_gate * xin
    E = t.shape[-1]
    pad = (CONV_WIDTH - 1) // 2
    conv = lax.conv_general_dilated(
        t, conv_k.astype(t.dtype)[:, None, :], window_strides=(1,), padding=[(pad, pad)],
        dimension_numbers=('NWC', 'WIO', 'NWC'), feature_group_count=E)
    return (b_gate * conv * jax.nn.silu(z)) @ w_out


def dilated_mixer(h, w_in, w_out, cos, sin):
    B, S, _ = h.shape
    G, H, Dh = len(DIL_RATES), DIL_HEADS, DIL_HEAD_DIM
    E = H * Dh
    q, k, v, z = jnp.split(h @ w_in, [G * E, 2 * G * E, 2 * G * E + E], axis=-1)
    q = apply_rope(q.reshape(B, S, G, H, Dh), cos, sin)
    k = apply_rope(k.reshape(B, S, G, H, Dh), cos, sin)
    v = v.reshape(B, S, H, Dh)
    outs, lses = [], []
    for g in range(G):
        r = DIL_RATES[g]
        half = DIL_WINDOWS[g] // (2 * r)
        o, lse = banded_attention(to_strided(q[:, :, g], r)[:, :, :, None],
                                  to_strided(k[:, :, g], r), to_strided(v, r), half)
        outs.append(from_strided(o[:, :, :, 0], r, B))
        lses.append(from_strided(lse[..., 0], r, B))
    wts = jax.nn.softmax(jnp.stack(lses, axis=0), axis=0)
    o = jnp.sum(wts[..., None] * jnp.stack(outs, axis=0), axis=0)
    y = o.reshape(B, S, E).astype(h.dtype) * jax.nn.silu(z)
    return y @ w_out


def window_gqa_mixer(h, w_in, sink, w_out, cos, sin):
    B, S, _ = h.shape
    Hq, Hk, Dh = SWA_Q_HEADS, SWA_KV_HEADS, SWA_HEAD_DIM
    G = Hq // Hk
    q, k, v, z = jnp.split(h @ w_in, [Hq * Dh, Hq * Dh + Hk * Dh, Hq * Dh + 2 * Hk * Dh], axis=-1)
    q = apply_rope(q.reshape(B, S, Hk, G, Dh), cos, sin)
    k = apply_rope(k.reshape(B, S, Hk, Dh), cos, sin)
    v = v.reshape(B, S, Hk, Dh)
    o, _ = banded_attention(q, k, v, SWA_HALF, sink.reshape(Hk, G))
    y = o.reshape(B, S, Hq * Dh).astype(h.dtype) * jax.nn.silu(z)
    return y @ w_out


def diff_attention_mixer(h, w_in, lam_vecs, subln_g, w_out, cos, sin, layer_idx):
    B, S, _ = h.shape
    H, d = DIFF_HEADS, DIFF_HEAD_DIM
    q, k, v, z = jnp.split(h @ w_in, 4, axis=-1)
    q = apply_rope(q.reshape(B, S, H, 2, d), cos, sin)
    k = apply_rope(k.reshape(B, S, H, 2, d), cos, sin)
    v = v.reshape(B, S, H, 2 * d).astype(jnp.float32)
    lam_init = 0.8 - 0.6 * math.exp(-0.3 * layer_idx)
    lv = lam_vecs.astype(jnp.float32)
    lam = jnp.exp(jnp.sum(lv[0] * lv[1])) - jnp.exp(jnp.sum(lv[2] * lv[3])) + lam_init
    nb = S // Q_BLOCK
    qb = jnp.moveaxis(q.reshape(B, nb, Q_BLOCK, H, 2, d), 1, 0)
    scale = d ** -0.5

    def block(qs):
        s = jnp.einsum('bqhcd,bkhcd->bhcqk', qs, k, preferred_element_type=jnp.float32) * scale
        p = jax.nn.softmax(s, axis=-1)
        a = p[:, :, 0] - lam * p[:, :, 1]
        return jnp.einsum('bhqk,bkhe->bqhe', a, v)

    o = jnp.moveaxis(lax.map(block, qb), 0, 1).reshape(B, S, H, 2 * d)
    o = rms_norm(o, subln_g, SUBLN_EPS) * (1.0 - lam_init)
    y = o.reshape(B, S, H * 2 * d).astype(h.dtype) * jax.nn.silu(z)
    return y @ w_out


def setup_inputs(seed: int = 0) -> dict:
    key = jax.random.key(seed)
    ks = iter(jax.random.split(key, 32))
    nrm = lambda shape, s: jax.random.normal(next(ks), shape, jnp.float32) * s
    D = D_MODEL
    nA, nB, nC, nD = (_layers_of_type(t) for t in range(N_MIXERS))
    G = len(DIL_RATES)
    swa_in = 2 * SWA_DIM + 2 * SWA_KV_HEADS * SWA_HEAD_DIM
    return dict(
        x=nrm((BATCH, SEQ, D), 1.0),
        c=nrm((BATCH, D), 1.0),
        norm_g=1.0 + nrm((DEPTH, D), 0.02),
        w_mod=nrm((DEPTH, D, 3 * D), 0.5 * D ** -0.5),
        b_mod=nrm((DEPTH, 3 * D), 0.02),
        conv_w_in=nrm((nA, D, 4 * CONV_DIM), D ** -0.5),
        conv_k=nrm((nA, CONV_WIDTH, CONV_DIM), CONV_WIDTH ** -0.5),
        conv_w_out=nrm((nA, CONV_DIM, D), CONV_DIM ** -0.5),
        dil_w_in=nrm((nB, D, (2 * G + 2) * DIL_DIM), D ** -0.5),
        dil_w_out=nrm((nB, DIL_DIM, D), DIL_DIM ** -0.5),
        swa_w_in=nrm((nC, D, swa_in), D ** -0.5),
        swa_sink=nrm((nC, SWA_Q_HEADS), 1.0),
        swa_w_out=nrm((nC, SWA_DIM, D), SWA_DIM ** -0.5),
        diff_w_in=nrm((nD, D, 4 * DIFF_DIM), D ** -0.5),
        diff_lambda=nrm((nD, 4, DIFF_HEAD_DIM), 0.1),
        diff_subln_g=1.0 + nrm((nD, 2 * DIFF_HEAD_DIM), 0.02),
        diff_w_out=nrm((nD, DIFF_DIM, D), DIFF_DIM ** -0.5),
        final_g=1.0 + nrm((D,), 0.02),
    )


def reference(x, c, norm_g, w_mod, b_mod, conv_w_in, conv_k, conv_w_out, dil_w_in, dil_w_out,
              swa_w_in, swa_sink, swa_w_out, diff_w_in, diff_lambda, diff_subln_g, diff_w_out,
              final_g):
    S = x.shape[1]
    cos_dil, sin_dil = rope_tables(S, DIL_HEAD_DIM)
    cos_swa, sin_swa = rope_tables(S, SWA_HEAD_DIM)
    cos_diff, sin_diff = rope_tables(S, DIFF_HEAD_DIM)
    for i in range(DEPTH):
        kind, j = i % N_MIXERS, i // N_MIXERS
        h, gate = adaln_pre_norm(x, c, norm_g[i], w_mod[i], b_mod[i])
        if kind == 0:
            y = short_conv_mixer(h, conv_w_in[j], conv_k[j], conv_w_out[j])
        elif kind == 1:
            y = dilated_mixer(h, dil_w_in[j], dil_w_out[j], cos_dil, sin_dil)
        elif kind == 2:
            y = window_gqa_mixer(h, swa_w_in[j], swa_sink[j], swa_w_out[j], cos_swa, sin_swa)
        else:
            y = diff_attention_mixer(h, diff_w_in[j], diff_lambda[j], diff_subln_g[j],
                                     diff_w_out[j], cos_diff, sin_diff, i)
        x = x + gate[:, None, :] * y
    return rms_norm(x, final_g, NORM_EPS)
```

```cpp
#include <hip/hip_runtime.h>
#include <hip/hip_cooperative_groups.h>
#include <cstdio>
#include <cstdint>
#include <cmath>
namespace cg = cooperative_groups;

#define LAS __attribute__((address_space(3)))
typedef unsigned short bf16_t;
typedef short bf16x8 __attribute__((ext_vector_type(8)));
typedef short s16x4 __attribute__((ext_vector_type(4)));
typedef float f32x4 __attribute__((ext_vector_type(4)));
typedef float f32x16 __attribute__((ext_vector_type(16)));
typedef unsigned u32x4 __attribute__((ext_vector_type(4)));
typedef unsigned u32x2 __attribute__((ext_vector_type(2)));

constexpr int DM = 1024, NB = 4, SEQ = 8192, MTOK = NB * SEQ;
constexpr float LOG2E = 1.4426950408889634f;

constexpr size_t MiB = 1024ull * 1024ull;
constexpr size_t WS_BAR = 0;
constexpr size_t WS_KMAX = 14336;
constexpr size_t WS_MOD = 16384;
constexpr size_t WS_COS128 = 1 * MiB;
constexpr size_t WS_SIN128 = 3 * MiB;
constexpr size_t WS_COS64 = 5 * MiB;
constexpr size_t WS_SIN64 = 6 * MiB;
constexpr size_t WS_WT = 7 * MiB;
constexpr size_t WS_H = 52 * MiB;
constexpr size_t WS_OG = 116 * MiB;
constexpr size_t WS_LSE = 212 * MiB;
constexpr size_t WS_PROJ = 214 * MiB;
constexpr size_t WS_END = 470 * MiB;
constexpr int WR_CONV_IN = 0, WR_CONV_OUT = 4096, WR_DIL_IN = 5120, WR_DIL_OUT = 13312, WR_SWA_IN = 14336, WR_SWA_OUT = 16896, WR_DIFF_IN = 17920, WR_DIFF_OUT = 22016;

struct Params {
    const float* x; const float* c; const float* norm_g; const float* w_mod; const float* b_mod;
    const float* conv_w_in; const float* conv_k; const float* conv_w_out;
    const float* dil_w_in; const float* dil_w_out;
    const float* swa_w_in; const float* swa_sink; const float* swa_w_out;
    const float* diff_w_in; const float* diff_lambda; const float* diff_subln_g; const float* diff_w_out;
    const float* final_g;
    float* out; unsigned char* ws;
    float inv128[64]; float inv64[32];
    float lam_init; int ph_lo; int ph_hi; float one_minus_lam_init;
};

typedef __bf16 bf16v2 __attribute__((ext_vector_type(2)));
typedef float f32x2 __attribute__((ext_vector_type(2)));
__device__ __forceinline__ unsigned pk_bf16(float lo, float hi) { const f32x2 v = {lo, hi}; const bf16v2 b = __builtin_convertvector(v, bf16v2); return __builtin_bit_cast(unsigned, b); }
__device__ __forceinline__ float bf_lo(unsigned u) { return __uint_as_float(u << 16); }
__device__ __forceinline__ float bf_hi(unsigned u) { return __uint_as_float(u & 0xffff0000u); }
__device__ __forceinline__ float silu_f(float v) { return v * __builtin_amdgcn_rcpf(1.0f + __builtin_amdgcn_exp2f(-LOG2E * v)); }
__device__ __forceinline__ int tid_opaque() { int t = threadIdx.x; asm volatile("" : "+v"(t)); return t; }
template <int X> __device__ __forceinline__ float swz_xor(float v) { return __int_as_float(__builtin_amdgcn_ds_swizzle(__float_as_int(v), 0x1f | (X << 10))); }
__device__ __forceinline__ float xor32(float v, int x32a) { return __int_as_float(__builtin_amdgcn_ds_bpermute(x32a, __float_as_int(v))); }
__device__ __forceinline__ float wave_sum(float v, int x32a) {
    v += swz_xor<1>(v); v += swz_xor<2>(v); v += swz_xor<4>(v); v += swz_xor<8>(v); v += swz_xor<16>(v); v += xor32(v, x32a);
    return v;
}

namespace gm {
constexpr int BM = 256, BK = 64, HALF = 128, HTB = HALF * BK * 2, KD = 1024, NT = KD / BK, NXCD = 8, WGM = 8;
__device__ __forceinline__ void stage_rc(int b, int& R, int& C) { const int st = b / 1024, sb = b % 1024, swz = sb ^ (((sb >> 9) & 1) << 5); R = (st >> 1) * 16 + swz / 64; C = (st & 1) * 32 + (swz % 64) / 2; }

#define GM_WAIT_V(n) asm volatile("s_waitcnt vmcnt(" #n ")" ::: "memory")
#define GM_WAIT_L(n) asm volatile("s_waitcnt lgkmcnt(" #n ")" ::: "memory")
#define GM_BAR __builtin_amdgcn_s_barrier()
#define GM_SCHED __builtin_amdgcn_sched_barrier(0)

template <class Epi>
__device__ __forceinline__ void gemm_phase(const bf16_t* __restrict__ A, const bf16_t* __restrict__ Bt, int M, int N, LAS unsigned char* lds, const Epi& epi, int vcu) {
    int tid = threadIdx.x; asm volatile("" : "+v"(tid));
    const int wid = tid >> 6, lane = tid & 63, wr = __builtin_amdgcn_readfirstlane(wid >> 2), wc = __builtin_amdgcn_readfirstlane(wid & 3), fr = lane & 15, fq = lane >> 4;
    int sr0, sc0, sr1, sc1; stage_rc(tid * 16, sr0, sc0); stage_rc(tid * 16 + 8192, sr1, sc1);
    const unsigned soff0 = (unsigned)(sr0 * KD + sc0) * 2u, soff1 = (unsigned)(sr1 * KD + sc1) * 2u;
    const int ob = fr * 64 + fq * 16, obs = ob ^ (((ob >> 9) & 1) << 5);
    const int aoff = wr * 8192 + obs, boff = wc * 4096 + obs;
    const int nM = M / BM, nN = N / BM, nwg = nM * nN;
#define GM_SA(b, h) (lds + ((b) * 2 + (h)) * HTB)
#define GM_SB(b, h) (lds + (4 + (b) * 2 + (h)) * HTB)
#define GM_STAGE(P, BASE, br, kt) do { const char* _g = (const char*)((BASE) + (size_t)(br) * KD + (kt) * BK); \
        unsigned _o0 = soff0, _o1 = soff1; asm volatile("" : "+v"(_o0), "+v"(_o1)); \
        __builtin_amdgcn_global_load_lds((const void*)(_g + _o0), (LAS void*)((P) + tid * 16), 16, 0, 0); \
        __builtin_amdgcn_global_load_lds((const void*)(_g + _o1), (LAS void*)((P) + tid * 16 + 8192), 16, 0, 0); } while (0)
#define GM_LDA(dst, b, h) _Pragma("unroll") for (int m = 0; m < 4; ++m) _Pragma("unroll") for (int k = 0; k < 2; ++k) \
        dst[m][k] = *(const LAS bf16x8*)(GM_SA(b, h) + aoff + (m * 2 + k) * 1024)
#define GM_LDB(dst, b, h) _Pragma("unroll") for (int n = 0; n < 2; ++n) _Pragma("unroll") for (int k = 0; k < 2; ++k) \
        dst[n][k] = *(const LAS bf16x8*)(GM_SB(b, h) + boff + (n * 2 + k) * 1024)
#define GM_MMA(ai, bj, At, Bv) do { __builtin_amdgcn_s_setprio(1); \
        _Pragma("unroll") for (int m = 0; m < 4; ++m) _Pragma("unroll") for (int n = 0; n < 2; ++n) _Pragma("unroll") for (int k = 0; k < 2; ++k) \
            acc[ai][bj][m][n] = __builtin_amdgcn_mfma_f32_16x16x32_bf16(Bv[n][k], At[m][k], acc[ai][bj][m][n], 0, 0, 0); \
        __builtin_amdgcn_s_setprio(0); } while (0)
    auto tile_rc = [&](int it, int& brow, int& bcol) -> bool {
        const long Lq = (long)it * gridDim.x + vcu; if (Lq >= nwg) return false;
        int wgid = (int)Lq; { const int q = nwg / NXCD, r = nwg % NXCD, xcd = wgid % NXCD, off = wgid / NXCD; wgid = (xcd < r ? xcd * (q + 1) : r * (q + 1) + (xcd - r) * q) + off; }
        const int nig = WGM * nN, gid = wgid / nig, fm = gid * WGM, gsz = (nM - fm) < WGM ? (nM - fm) : WGM;
        brow = (fm + ((wgid % nig) % gsz)) * BM; bcol = ((wgid % nig) / gsz) * BM; return true;
    };
    int brow = 0, bcol = 0;
    if (!tile_rc(0, brow, bcol)) return;
    GM_STAGE(GM_SB(0, 0), Bt, bcol, 0); GM_STAGE(GM_SA(0, 0), A, brow, 0); GM_STAGE(GM_SB(0, 1), Bt, bcol + HALF, 0); GM_STAGE(GM_SA(0, 1), A, brow + HALF, 0);
    if (wr == 1) GM_BAR;
    GM_WAIT_V(4); GM_BAR;
    GM_STAGE(GM_SB(1, 0), Bt, bcol, 1); GM_STAGE(GM_SA(1, 0), A, brow, 1); GM_STAGE(GM_SB(1, 1), Bt, bcol + HALF, 1);
    GM_WAIT_V(6); GM_BAR;
    for (int it = 0;; ++it) {
        int nrow = brow, ncol = bcol;
        const bool have_next = tile_rc(it + 1, nrow, ncol);
        f32x4 acc[2][2][4][2];
#pragma unroll
        for (int a = 0; a < 2; ++a)
#pragma unroll
            for (int b = 0; b < 2; ++b)
#pragma unroll
                for (int m = 0; m < 4; ++m)
#pragma unroll
                    for (int n = 0; n < 2; ++n) acc[a][b][m][n] = (f32x4){0.f, 0.f, 0.f, 0.f};
        bf16x8 At[4][2], B0[2][2], B1[2][2];
        for (int t = 0; t < NT; t += 2) {
            const bool lastk = (t + 2 >= NT);
            const int prow = lastk ? nrow : brow, pcol = lastk ? ncol : bcol, k2 = lastk ? 0 : t + 2, k3 = lastk ? 1 : t + 3;
            GM_LDB(B0, 0, 0); GM_SCHED; GM_LDA(At, 0, 0); GM_STAGE(GM_SA(1, 1), A, brow + HALF, t + 1);
            GM_WAIT_L(8); GM_BAR; GM_WAIT_L(0); GM_MMA(0, 0, At, B0); GM_BAR; GM_SCHED;
            GM_LDB(B1, 0, 1); GM_STAGE(GM_SB(0, 0), Bt, pcol, k2);
            GM_BAR; GM_WAIT_L(0); GM_MMA(0, 1, At, B1); GM_BAR;
            GM_LDA(At, 0, 1); GM_STAGE(GM_SA(0, 0), A, prow, k2);
            GM_BAR; GM_WAIT_L(0); GM_MMA(1, 0, At, B0); GM_BAR; GM_SCHED;
            GM_STAGE(GM_SB(0, 1), Bt, pcol + HALF, k2);
            GM_WAIT_V(6); GM_BAR; GM_MMA(1, 1, At, B1); GM_BAR;
            GM_LDB(B0, 1, 0); GM_SCHED; GM_LDA(At, 1, 0); GM_STAGE(GM_SA(0, 1), A, prow + HALF, k2);
            GM_WAIT_L(8); GM_BAR; GM_WAIT_L(0); GM_MMA(0, 0, At, B0); GM_BAR; GM_SCHED;
            GM_LDB(B1, 1, 1); GM_STAGE(GM_SB(1, 0), Bt, pcol, k3);
            GM_BAR; GM_WAIT_L(0); GM_MMA(0, 1, At, B1); GM_BAR;
            GM_LDA(At, 1, 1); GM_STAGE(GM_SA(1, 0), A, prow, k3);
            GM_BAR; GM_WAIT_L(0); GM_MMA(1, 0, At, B0); GM_BAR; GM_SCHED;
            GM_STAGE(GM_SB(1, 1), Bt, pcol + HALF, k3);
            GM_WAIT_V(6); GM_BAR; GM_MMA(1, 1, At, B1); GM_BAR;
        }
        {
        int fre = fr, fqe = fq; asm volatile("" : "+v"(fre), "+v"(fqe));
#pragma unroll
        for (int ai = 0; ai < 2; ++ai)
#pragma unroll
            for (int mp = 0; mp < 2; ++mp) {
#pragma unroll
                for (int mq = 0; mq < 2; ++mq)
#pragma unroll
                    for (int bj = 0; bj < 2; ++bj) { const int m = mp * 2 + mq;
                        epi(brow + ai * HALF + wr * 64 + m * 16 + fre, (bcol + bj * HALF + wc * 32) >> 5, fqe, acc[ai][bj][m][0], acc[ai][bj][m][1]); }
                GM_SCHED;
            }
        }
        if (!have_next) break;
        brow = nrow; bcol = ncol;
    }
    GM_WAIT_V(0);
    if (wr == 0) GM_BAR;
}
}

struct EpiRope {
    bf16_t* out; int ld; int rope_end; int q_end; int hd; const float* cosT; const float* sinT; float qscale;
    __device__ __forceinline__ void operator()(int row, int G, int fq, f32x4 v0, f32x4 v1) const {
        const int col32 = G * 32;
        const unsigned ro = (unsigned)row * (unsigned)ld;
        if (col32 < rope_end) {
            const int half = hd >> 1, hb = col32 & ~(hd - 1), d0 = ((col32 & (hd - 1)) >> 5) * 16 + fq * 4, pos = row & (SEQ - 1);
            const unsigned to = (unsigned)(pos * half + d0);
            const f32x4 c = *(const f32x4*)(cosT + to), s = *(const f32x4*)(sinT + to);
            const f32x4 o1 = v0 * c - v1 * s, o2 = v1 * c + v0 * s;
            u32x2 w1, w2; w1.x = pk_bf16(o1[0], o1[1]); w1.y = pk_bf16(o1[2], o1[3]); w2.x = pk_bf16(o2[0], o2[1]); w2.y = pk_bf16(o2[2], o2[3]);
            *(u32x2*)(out + (ro + (unsigned)(hb + d0))) = w1; *(u32x2*)(out + (ro + (unsigned)(hb + half + d0))) = w2;
        } else {
            u32x4 w; w.x = pk_bf16(v0[0], v0[1]); w.y = pk_bf16(v0[2], v0[3]); w.z = pk_bf16(v1[0], v1[1]); w.w = pk_bf16(v1[2], v1[3]);
            *(u32x4*)(out + (ro + (unsigned)(col32 + 8 * fq))) = w;
        }
    }
};
struct EpiConv {
    bf16_t* out;
    __device__ __forceinline__ void operator()(int row, int G, int fq, f32x4 v0, f32x4 v1) const {
        f32x4 r;
        if (G < 64) r = v0 * v1;
        else { r[0] = v0[0] * silu_f(v1[0]); r[1] = v0[1] * silu_f(v1[1]); r[2] = v0[2] * silu_f(v1[2]); r[3] = v0[3] * silu_f(v1[3]); }
        u32x2 w; w.x = pk_bf16(r[0], r[1]); w.y = pk_bf16(r[2], r[3]);
        *(u32x2*)(out + ((unsigned)row * 2048u + (unsigned)(G * 16 + 4 * fq))) = w;
    }
};
struct EpiRes {
    const float* xin; float* xout; const float* gate;
    __device__ __forceinline__ void operator()(int row, int G, int fq, f32x4 v0, f32x4 v1) const {
        const int col = G * 32 + 8 * fq, b = row >> 13;
        const unsigned xo = (unsigned)row * (unsigned)DM + (unsigned)col;
        const float* gp = gate + (unsigned)(b * 3072 + col); const float* xp = xin + xo; float* op = xout + xo;
        const f32x4 g0 = *(const f32x4*)gp, g1 = *(const f32x4*)(gp + 4), x0 = *(const f32x4*)xp, x1 = *(const f32x4*)(xp + 4);
        *(f32x4*)op = x0 + g0 * v0; *(f32x4*)(op + 4) = x1 + g1 * v1;
    }
};

__device__ __forceinline__ int srccol(int kind, int rope_end, int n) {
    if (kind == 1) { const int G = n >> 5, nn = (n >> 4) & 1, i = n & 15; return G < 64 ? (nn ? 2048 : 1024) + 16 * G + i : (nn ? 3072 : 0) + 16 * (G - 64) + i; }
    if (kind >= 2 && n < rope_end) { const int hd = kind == 2 ? 128 : 64; const int hb = n & ~(hd - 1), r = n & (hd - 1), gg = r >> 5, nn = (r >> 4) & 1, i = r & 15; return hb + (hd >> 1) * nn + 16 * gg + i; }
    return (n & ~31) | (((n >> 2) & 3) << 3) | (((n >> 4) & 1) << 2) | (n & 3);
}
__device__ __forceinline__ void transpose_item(const float* __restrict__ W, int N, int kind, int rope_end, bf16_t* __restrict__ WT, int n0, int k0, LAS unsigned char* lds, int q_end, float qscale) {
    LAS bf16_t* tile = (LAS bf16_t*)lds;
    const int t = tid_opaque(), kk = t >> 4, nn4 = (t & 15) * 4;
    const int src = srccol(kind, rope_end, n0 + nn4);
    const float wsc = (n0 + nn4 < q_end) ? qscale : 1.0f;
#pragma unroll
    for (int i = 0; i < 2; ++i) { const int k = kk + 32 * i; const f32x4 w = *(const f32x4*)(W + (size_t)(k0 + k) * N + src) * wsc;
        const unsigned a = pk_bf16(w[0], w[1]), b = pk_bf16(w[2], w[3]);
        tile[(nn4 + 0) * 72 + k] = (bf16_t)(a & 0xffff); tile[(nn4 + 1) * 72 + k] = (bf16_t)(a >> 16); tile[(nn4 + 2) * 72 + k] = (bf16_t)(b & 0xffff); tile[(nn4 + 3) * 72 + k] = (bf16_t)(b >> 16); }
    __syncthreads();
    { const int n = t >> 3, kc = (t & 7) * 8; const u32x4 v = *(const LAS u32x4*)(tile + n * 72 + kc); *(u32x4*)(WT + (size_t)(n0 + n) * 1024 + k0 + kc) = v; }
    __syncthreads();
}
__device__ __forceinline__ void mod_item(const Params& p, int layer, int cc, LAS unsigned char* lds) {
    LAS float* sc = (LAS float*)lds;
    LAS float* red = (LAS float*)(lds + 16384);
    const int t = tid_opaque(), w = t >> 6, lane = t & 63;
#pragma unroll
    for (int i = 0; i < 8; ++i) { const int idx = t + 512 * i; sc[idx] = silu_f(p.c[idx]); }
    __syncthreads();
    const float* W = p.w_mod + (size_t)layer * DM * 3072 + cc * 64 + lane;
    float a0 = 0.f, a1 = 0.f, a2 = 0.f, a3 = 0.f;
#pragma unroll 8
    for (int kk = 0; kk < 128; ++kk) { const int k = w * 128 + kk; const float wv = W[(size_t)k * 3072];
        a0 += sc[k] * wv; a1 += sc[1024 + k] * wv; a2 += sc[2048 + k] * wv; a3 += sc[3072 + k] * wv; }
    red[(w * 4 + 0) * 64 + lane] = a0; red[(w * 4 + 1) * 64 + lane] = a1; red[(w * 4 + 2) * 64 + lane] = a2; red[(w * 4 + 3) * 64 + lane] = a3;
    __syncthreads();
    if (t < 256) { const int b = t >> 6, col = t & 63; float s = 0.f;
#pragma unroll
        for (int ww = 0; ww < 8; ++ww) s += red[(ww * 4 + b) * 64 + col];
        ((float*)(p.ws + WS_MOD))[((size_t)layer * 4 + b) * 3072 + cc * 64 + col] = s + p.b_mod[layer * 3072 + cc * 64 + col]; }
    __syncthreads();
}
__device__ __forceinline__ void sincos_d(double a, float& c, float& s) {
    const double TWO_PI = 6.283185307179586476925286766559, INV_TWO_PI = 0.15915494309189533576888376337251;
    const double k = __builtin_rint(a * INV_TWO_PI); const double r = a - k * TWO_PI, r2 = r * r;
    double tc = 1.0, sumc = 1.0, ts = r, sums = r;
#pragma unroll
    for (int n = 1; n <= 13; ++n) { tc = -tc * r2 * (1.0 / (double)((2 * n - 1) * (2 * n))); sumc += tc; ts = -ts * r2 * (1.0 / (double)((2 * n) * (2 * n + 1))); sums += ts; }
    c = (float)sumc; s = (float)sums;
}
__device__ __forceinline__ void prologue_phase(const Params& p, LAS unsigned char* lds) {
    constexpr int T_ITEMS = 5760, M_ITEMS = 192, R_ITEMS = 1536;
    bf16_t* WT = (bf16_t*)(p.ws + WS_WT);
    for (int it = blockIdx.x; it < T_ITEMS + M_ITEMS + R_ITEMS; it += gridDim.x) {
        if (it < M_ITEMS) { mod_item(p, it / 48, it % 48, lds); continue; }
        int r = it - M_ITEMS;
        if (r < T_ITEMS) {
            const float* W; int N, kind, rope_end, wr, q_end = 0; float qs = 1.0f;
            if (r < 1024) { W = p.conv_w_in; N = 4096; kind = 1; rope_end = 0; wr = WR_CONV_IN; }
            else if ((r -= 1024) < 256) { W = p.conv_w_out; N = 1024; kind = 0; rope_end = 0; wr = WR_CONV_OUT; }
            else if ((r -= 256) < 2048) { W = p.dil_w_in; N = 8192; kind = 2; rope_end = 6144; wr = WR_DIL_IN; q_end = 3072; qs = 0.08838834764831845f * LOG2E; }
            else if ((r -= 2048) < 256) { W = p.dil_w_out; N = 1024; kind = 0; rope_end = 0; wr = WR_DIL_OUT; }
            else if ((r -= 256) < 640) { W = p.swa_w_in; N = 2560; kind = 3; rope_end = 1280; wr = WR_SWA_IN; q_end = 1024; qs = 0.125f * LOG2E; }
            else if ((r -= 640) < 256) { W = p.swa_w_out; N = 1024; kind = 0; rope_end = 0; wr = WR_SWA_OUT; }
            else if ((r -= 256) < 1024) { W = p.diff_w_in; N = 4096; kind = 3; rope_end = 2048; wr = WR_DIFF_IN; q_end = 1024; qs = 0.125f * LOG2E; }
            else { r -= 1024; W = p.diff_w_out; N = 1024; kind = 0; rope_end = 0; wr = WR_DIFF_OUT; }
            const int ntile = r >> 4, ktile = r & 15;
            transpose_item(W, N, kind, rope_end, WT + (size_t)wr * 1024, ntile * 64, ktile * 64, lds, q_end, qs);
            continue;
        }
        r -= T_ITEMS;
        const int idx = r * 512 + tid_opaque();
        if (idx < SEQ * 64) { const int pos = idx >> 6, i = idx & 63; const float ang = (float)pos * p.inv128[i]; float c, s; sincos_d((double)ang, c, s);
            ((float*)(p.ws + WS_COS128))[idx] = c; ((float*)(p.ws + WS_SIN128))[idx] = s; }
        else { const int j = idx - SEQ * 64, pos = j >> 5, i = j & 31; const float ang = (float)pos * p.inv64[i]; float c, s; sincos_d((double)ang, c, s);
            ((float*)(p.ws + WS_COS64))[j] = c; ((float*)(p.ws + WS_SIN64))[j] = s; }
    }
}

__device__ __forceinline__ void norm_phase(const Params& p, int layer) {
    const float* src = layer == 0 ? p.x : p.out; const float* g = p.norm_g + layer * DM; const float* mod = (const float*)(p.ws + WS_MOD) + (size_t)layer * 4 * 3072;
    bf16_t* H = (bf16_t*)(p.ws + WS_H);
    const int tid = tid_opaque(), lane = tid & 63, gw = blockIdx.x * 8 + (tid >> 6), ngw = gridDim.x * 8, x32a = ((lane ^ 32) << 2);
    constexpr int RPW = 16;
    for (int r0 = gw * RPW; r0 < MTOK; r0 += ngw * RPW) {
        const float* mb = mod + (r0 >> 13) * 3072;
        f32x4 gs[4], sh[4];
#pragma unroll
        for (int j = 0; j < 4; ++j) { const int col = 4 * lane + 256 * j; gs[j] = *(const f32x4*)(g + col) * (*(const f32x4*)(mb + 1024 + col) + 1.0f); sh[j] = *(const f32x4*)(mb + col); }
        constexpr int RIF = 4;
        for (int rr = 0; rr < RPW; rr += RIF) {
            const int row = r0 + rr;
            f32x4 v[RIF][4]; float ssq[RIF];
#pragma unroll
            for (int q = 0; q < RIF; ++q) { const f32x4* xr = (const f32x4*)(src + (size_t)(row + q) * DM) + lane;
#pragma unroll
                for (int j = 0; j < 4; ++j) v[q][j] = xr[64 * j]; }
#pragma unroll
            for (int q = 0; q < RIF; ++q) { float s = 0.f;
#pragma unroll
                for (int j = 0; j < 4; ++j) s += (v[q][j][0] * v[q][j][0] + v[q][j][1] * v[q][j][1]) + (v[q][j][2] * v[q][j][2] + v[q][j][3] * v[q][j][3]);
                ssq[q] = rsqrtf(wave_sum(s, x32a) * (1.0f / DM) + 1e-6f); }
#pragma unroll
            for (int q = 0; q < RIF; ++q)
#pragma unroll
                for (int j = 0; j < 4; ++j) { const int col = 4 * lane + 256 * j; const f32x4 y = (v[q][j] * ssq[q]) * gs[j] + sh[j];
                    u32x2 w; w.x = pk_bf16(y[0], y[1]); w.y = pk_bf16(y[2], y[3]); *(u32x2*)(H + (size_t)(row + q) * DM + col) = w; }
        }
    }
}
__device__ __forceinline__ void final_phase(const Params& p) {
    const int tid = tid_opaque(), lane = tid & 63, gw = blockIdx.x * 8 + (tid >> 6), ngw = gridDim.x * 8, x32a = ((lane ^ 32) << 2);
    constexpr int RPW = 16;
    f32x4 gg[4];
#pragma unroll
    for (int j = 0; j < 4; ++j) gg[j] = *(const f32x4*)(p.final_g + 4 * lane + 256 * j);
    for (int r0 = gw * RPW; r0 < MTOK; r0 += ngw * RPW) {
        constexpr int RIF = 4;
        for (int rr = 0; rr < RPW; rr += RIF) {
            f32x4 v[RIF][4]; float ssq[RIF];
#pragma unroll
            for (int q = 0; q < RIF; ++q) { const f32x4* xr = (const f32x4*)(p.out + (size_t)(r0 + rr + q) * DM) + lane;
#pragma unroll
                for (int j = 0; j < 4; ++j) v[q][j] = xr[64 * j]; }
#pragma unroll
            for (int q = 0; q < RIF; ++q) { float s = 0.f;
#pragma unroll
                for (int j = 0; j < 4; ++j) s += (v[q][j][0] * v[q][j][0] + v[q][j][1] * v[q][j][1]) + (v[q][j][2] * v[q][j][2] + v[q][j][3] * v[q][j][3]);
                ssq[q] = rsqrtf(wave_sum(s, x32a) * (1.0f / DM) + 1e-6f); }
#pragma unroll
            for (int q = 0; q < RIF; ++q) { f32x4* xw = (f32x4*)(p.out + (size_t)(r0 + rr + q) * DM) + lane;
#pragma unroll
                for (int j = 0; j < 4; ++j) xw[64 * j] = (v[q][j] * ssq[q]) * gg[j]; }
        }
    }
}
__device__ __forceinline__ void conv_phase(const Params& p) {
    const bf16_t* TU = (const bf16_t*)(p.ws + WS_PROJ); bf16_t* Y = (bf16_t*)(p.ws + WS_H);
    const int nth = gridDim.x * 512;
    for (int idx = blockIdx.x * 512 + tid_opaque(); idx < MTOK * 128; idx += nth) {
        const int row = idx >> 7, e = (idx & 127) * 8, s = row & (SEQ - 1);
        const bf16_t* tp = TU + (size_t)row * 2048 + e;
        const u32x4 t1 = *(const u32x4*)tp, uu = *(const u32x4*)(tp + 1024);
        u32x4 t0 = (u32x4){0, 0, 0, 0}, t2 = (u32x4){0, 0, 0, 0};
        if (s > 0) t0 = *(const u32x4*)(tp - 2048);
        if (s < SEQ - 1) t2 = *(const u32x4*)(tp + 2048);
        const f32x4 k0a = *(const f32x4*)(p.conv_k + e), k0b = *(const f32x4*)(p.conv_k + e + 4), k1a = *(const f32x4*)(p.conv_k + 1024 + e), k1b = *(const f32x4*)(p.conv_k + 1024 + e + 4),
                    k2a = *(const f32x4*)(p.conv_k + 2048 + e), k2b = *(const f32x4*)(p.conv_k + 2048 + e + 4);
        u32x4 o;
#pragma unroll
        for (int j = 0; j < 4; ++j) {
            const float ka0 = j < 2 ? k0a[2 * j] : k0b[2 * j - 4], kb0 = j < 2 ? k0a[2 * j + 1] : k0b[2 * j - 3];
            const float ka1 = j < 2 ? k1a[2 * j] : k1b[2 * j - 4], kb1 = j < 2 ? k1a[2 * j + 1] : k1b[2 * j - 3];
            const float ka2 = j < 2 ? k2a[2 * j] : k2b[2 * j - 4], kb2 = j < 2 ? k2a[2 * j + 1] : k2b[2 * j - 3];
            const float lo = bf_lo(uu[j]) * (ka0 * bf_lo(t0[j]) + ka1 * bf_lo(t1[j]) + ka2 * bf_lo(t2[j]));
            const float hi = bf_hi(uu[j]) * (kb0 * bf_hi(t0[j]) + kb1 * bf_hi(t1[j]) + kb2 * bf_hi(t2[j]));
            o[j] = pk_bf16(lo, hi);
        }
        *(u32x4*)(Y + (size_t)row * DM + e) = o;
    }
}
__device__ __forceinline__ void dil_combine_phase(const Params& p, int half) {
    const bf16_t* OG = (const bf16_t*)(p.ws + WS_OG); const float* LSE = (const float*)(p.ws + WS_LSE); const bf16_t* PROJ = (const bf16_t*)(p.ws + WS_PROJ);
    bf16_t* Y = (bf16_t*)(p.ws + WS_H) + (size_t)half * 16384 * DM;
    const int nth = gridDim.x * 512;
    for (int idx = blockIdx.x * 512 + tid_opaque(); idx < 16384 * 128; idx += nth) {
        const int row = idx >> 7, e = (idx & 127) * 8, h = e >> 7;
        const float l0 = LSE[(size_t)row * 8 + h], l1 = LSE[(size_t)(16384 + row) * 8 + h], l2 = LSE[(size_t)(32768 + row) * 8 + h];
        const float mx = fmaxf(l0, fmaxf(l1, l2)); float w0 = __builtin_amdgcn_exp2f(l0 - mx), w1 = __builtin_amdgcn_exp2f(l1 - mx), w2 = __builtin_amdgcn_exp2f(l2 - mx);
        const float inv = 1.0f / (w0 + w1 + w2); w0 *= inv; w1 *= inv; w2 *= inv;
        const u32x4 a = *(const u32x4*)(OG + (size_t)row * DM + e), b = *(const u32x4*)(OG + (size_t)(16384 + row) * DM + e), c = *(const u32x4*)(OG + (size_t)(32768 + row) * DM + e);
        const u32x4 z = *(const u32x4*)(PROJ + (size_t)row * 8192 + 7168 + e);
        u32x4 o;
#pragma unroll
        for (int j = 0; j < 4; ++j) {
            const float lo = (w0 * bf_lo(a[j]) + w1 * bf_lo(b[j]) + w2 * bf_lo(c[j])) * silu_f(bf_lo(z[j]));
            const float hi = (w0 * bf_hi(a[j]) + w1 * bf_hi(b[j]) + w2 * bf_hi(c[j])) * silu_f(bf_hi(z[j]));
            o[j] = pk_bf16(lo, hi);
        }
        *(u32x4*)(Y + (size_t)row * DM + e) = o;
    }
}

__device__ __forceinline__ bf16x8 tr_pair(const LAS unsigned char* a0, const LAS unsigned char* a1) {
    const s16x4 x = __builtin_amdgcn_ds_read_tr16_b64_v4i16((LAS s16x4*)a0), y = __builtin_amdgcn_ds_read_tr16_b64_v4i16((LAS s16x4*)a1);
    return __builtin_shufflevector(x, y, 0, 1, 2, 3, 4, 5, 6, 7);
}
__device__ __forceinline__ bf16x8 pack8(const f32x16& s, int o) {
    u32x4 w; w.x = pk_bf16(s[o + 0], s[o + 1]); w.y = pk_bf16(s[o + 2], s[o + 3]); w.z = pk_bf16(s[o + 4], s[o + 5]); w.w = pk_bf16(s[o + 6], s[o + 7]);
    return __builtin_bit_cast(bf16x8, w);
}
__device__ __forceinline__ float max3f(float a, float b, float c) { return __builtin_fmaxf(__builtin_fmaxf(a, b), c); }
__device__ __forceinline__ float max16(const f32x16& s) {
    float a = max3f(s[0], s[1], s[2]), b = max3f(s[3], s[4], s[5]); a = max3f(a, s[6], s[7]); b = max3f(b, s[8], s[9]); a = max3f(a, s[10], s[11]); b = max3f(b, s[12], s[13]);
    return max3f(a, b, __builtin_fmaxf(s[14], s[15]));
}
__device__ __forceinline__ float xmax32(float v) { const auto r = __builtin_amdgcn_permlane32_swap(__float_as_uint(v), __float_as_uint(v), false, false); return __builtin_fmaxf(__uint_as_float(r[0]), __uint_as_float(r[1])); }
__device__ __forceinline__ float xsum32(float v) { const auto r = __builtin_amdgcn_permlane32_swap(__float_as_uint(v), __float_as_uint(v), false, false); return __uint_as_float(r[0]) + __uint_as_float(r[1]); }
__device__ __forceinline__ float sum16(const f32x16& s) {
    return ((s[0] + s[1]) + (s[2] + s[3])) + ((s[4] + s[5]) + (s[6] + s[7])) + (((s[8] + s[9]) + (s[10] + s[11])) + ((s[12] + s[13]) + (s[14] + s[15])));
}

template <int HD, int DV, int HW, int MODE>
__device__ __forceinline__ void band_item(const bf16_t* __restrict__ qp, const bf16_t* __restrict__ kp, const bf16_t* __restrict__ vp, int ld, size_t tok0, int r, int L, int i0,
                                          float sink2, bf16_t* __restrict__ op, int old, float* __restrict__ lsep, const bf16_t* __restrict__ zp, LAS unsigned char* lds) {
    constexpr int CR = 128, RSK = HD * 2 + 16, RSV = DV * 2 + 64, KB = CR * RSK, NC = (256 + 2 * HW) / CR, KS = HD / 16, NTV = DV / 32;
    constexpr int KCH = HD / 8, VCH = DV / 8, KLD = KCH * CR / 512, VLD = VCH * CR / 512;
    int tid = threadIdx.x; asm volatile("" : "+v"(tid));
    const int w = __builtin_amdgcn_readfirstlane(tid >> 6), lane = tid & 63, ql = lane & 31, hh = lane >> 5;
    const int iw = i0 + 32 * w, x32a = ((lane ^ 32) << 2);
    LAS unsigned char* Kl = lds; LAS unsigned char* Vl = lds + KB;
    bf16x8 qf[KS];
    { const bf16_t* qrow = qp + (tok0 + (size_t)r * (iw + ql)) * ld + 8 * hh;
#pragma unroll
      for (int ks = 0; ks < KS; ++ks) qf[ks] = *(const bf16x8*)(qrow + 16 * ks); }
    f32x16 O[NTV];
#pragma unroll
    for (int t = 0; t < NTV; ++t)
#pragma unroll
        for (int i = 0; i < 16; ++i) O[t][i] = 0.f;
    float m = (MODE == 1) ? sink2 : -1e30f, l = (MODE == 1 && hh == 0) ? 1.0f : 0.f;
    const int pi = (ql & ~12) | ((ql & 4) << 1) | ((ql & 8) >> 1);
    const LAS unsigned char* kread = Kl + pi * RSK + 16 * hh;
    const int g16 = lane >> 4, i16 = lane & 15;
    const LAS unsigned char* vread = Vl + (8 * (g16 >> 1) + (i16 >> 2)) * RSV + (16 * (g16 & 1) + 4 * (i16 & 3)) * 2;
    u32x4 kreg[KLD], vreg[VLD];
    auto prefetch = [&](int c) {
        const int jc = i0 - HW + CR * c;
#pragma unroll
        for (int i = 0; i < KLD; ++i) { const int idx = tid + 512 * i, row = idx / KCH, ch = idx % KCH, j = jc + row;
            kreg[i] = (j >= 0 && j < L) ? *(const u32x4*)(kp + (tok0 + (size_t)r * j) * ld + ch * 8) : (u32x4){0, 0, 0, 0}; }
#pragma unroll
        for (int i = 0; i < VLD; ++i) { const int idx = tid + 512 * i, row = idx / VCH, ch = idx % VCH, j = jc + row;
            vreg[i] = (j >= 0 && j < L) ? *(const u32x4*)(vp + (tok0 + (size_t)r * j) * ld + ch * 8) : (u32x4){0, 0, 0, 0}; }
    };
    prefetch(0);
    for (int c = 0; c < NC; ++c) {
        const int jc = i0 - HW + CR * c;
        __syncthreads();
#pragma unroll
        for (int i = 0; i < KLD; ++i) { const int idx = tid + 512 * i, row = idx / KCH, ch = idx % KCH; *(LAS u32x4*)(Kl + row * RSK + ch * 16) = kreg[i]; }
#pragma unroll
        for (int i = 0; i < VLD; ++i) { const int idx = tid + 512 * i, row = idx / VCH, ch = idx % VCH; *(LAS u32x4*)(Vl + row * RSV + ch * 16) = vreg[i]; }
        __syncthreads();
        if (c + 1 < NC) prefetch(c + 1);
#pragma unroll
        for (int u = 0; u < CR / 32; ++u) {
            const int js = jc + 32 * u;
            if (js + 31 < iw - HW || js > iw + 31 + HW || js + 31 < 0 || js >= L) continue;
            f32x16 S;
#pragma unroll
            for (int i = 0; i < 16; ++i) S[i] = 0.f;
#pragma unroll
            for (int ks = 0; ks < KS; ++ks) { const bf16x8 kf = *(const LAS bf16x8*)(kread + (32 * u) * RSK + 32 * ks); S = __builtin_amdgcn_mfma_f32_32x32x16_bf16(kf, qf[ks], S, 0, 0, 0); }
            const bool full = (js >= iw + 31 - HW) && (js + 31 <= iw + HW) && js >= 0 && js + 31 < L;
            if (!full) {
                const int qi = iw + ql;
#pragma unroll
                for (int i = 0; i < 16; ++i) { const int j = js + (i & 7) + 8 * hh + 16 * (i >> 3); const int d = qi - j; const bool ok = (d <= HW) && (d >= -HW) && (j >= 0) && (j < L); S[i] = ok ? S[i] : -INFINITY; }
            }
            float mt = xmax32(max16(S));
            if (__any(mt > m + 8.0f)) {
                const float mn = fmaxf(m, mt), a = __builtin_amdgcn_exp2f(m - mn); l *= a; m = mn;
#pragma unroll
                for (int t = 0; t < NTV; ++t) O[t] = O[t] * a;
            }
#pragma unroll
            for (int i = 0; i < 16; ++i) S[i] = __builtin_amdgcn_exp2f(S[i] - m);
            l += sum16(S);
            const bf16x8 P0 = pack8(S, 0), P1 = pack8(S, 8);
#pragma unroll
            for (int t = 0; t < NTV; ++t) {
                const LAS unsigned char* vb = vread + (32 * u) * RSV + 64 * t;
                const bf16x8 v0 = tr_pair(vb, vb + 4 * RSV), v1 = tr_pair(vb + 16 * RSV, vb + 20 * RSV);
                O[t] = __builtin_amdgcn_mfma_f32_32x32x16_bf16(v0, P0, O[t], 0, 0, 0);
                O[t] = __builtin_amdgcn_mfma_f32_32x32x16_bf16(v1, P1, O[t], 0, 0, 0);
            }
        }
    }
    const float lt = xsum32(l), inv = 1.0f / lt;
    const size_t tok = tok0 + (size_t)r * (iw + ql);
    if (MODE == 0) {
        if (hh == 0) lsep[tok * 8] = m + __builtin_amdgcn_logf(lt);
#pragma unroll
        for (int t = 0; t < NTV; ++t)
#pragma unroll
            for (int i4 = 0; i4 < 4; ++i4) { u32x2 wv; wv.x = pk_bf16(O[t][4 * i4] * inv, O[t][4 * i4 + 1] * inv); wv.y = pk_bf16(O[t][4 * i4 + 2] * inv, O[t][4 * i4 + 3] * inv);
                *(u32x2*)(op + tok * old + 32 * t + 8 * i4 + 4 * hh) = wv; }
    } else {
#pragma unroll
        for (int t = 0; t < NTV; ++t)
#pragma unroll
            for (int i4 = 0; i4 < 4; ++i4) { const int dv = 32 * t + 8 * i4 + 4 * hh; const u32x2 z = *(const u32x2*)(zp + tok * ld + dv);
                u32x2 wv; wv.x = pk_bf16(O[t][4 * i4] * inv * silu_f(bf_lo(z.x)), O[t][4 * i4 + 1] * inv * silu_f(bf_hi(z.x))); wv.y = pk_bf16(O[t][4 * i4 + 2] * inv * silu_f(bf_lo(z.y)), O[t][4 * i4 + 3] * inv * silu_f(bf_hi(z.y)));
                *(u32x2*)(op + tok * old + dv) = wv; }
    }
    __syncthreads();
}

__device__ __forceinline__ void dil_attn_phase(const Params& p, int half, LAS unsigned char* lds) {
    const bf16_t* PROJ = (const bf16_t*)(p.ws + WS_PROJ); bf16_t* OG = (bf16_t*)(p.ws + WS_OG); float* LSE = (float*)(p.ws + WS_LSE);
    (void)half;
    for (int it = blockIdx.x; it < 1536; it += gridDim.x) {
        const int g = it >> 9, rem = it & 511, bl = rem >> 8, rest = rem & 255, h = rest & 7, cr = rest >> 3;
        const int r = g == 0 ? 1 : (g == 1 ? 4 : 16), L = SEQ / r, pr = cr % r, qc = cr / r;
        const size_t tok0 = (size_t)bl * SEQ + pr;
        band_item<128, 128, 64, 0>(PROJ + g * 1024 + h * 128, PROJ + 3072 + g * 1024 + h * 128, PROJ + 6144 + h * 128, 8192, tok0, r, L, qc * 256, 0.f,
                                   OG + (size_t)g * 16384 * DM + h * 128, DM, LSE + (size_t)g * 16384 * 8 + h, nullptr, lds);
    }
}
__device__ __forceinline__ void swa_attn_phase(const Params& p, LAS unsigned char* lds) {
    const bf16_t* PROJ = (const bf16_t*)(p.ws + WS_PROJ); bf16_t* Y = (bf16_t*)(p.ws + WS_H);
    for (int it = blockIdx.x; it < 2048; it += gridDim.x) {
        const int h = it & 15, rest = it >> 4, qc = rest & 31, b = rest >> 5;
        band_item<64, 64, 128, 1>(PROJ + h * 64, PROJ + 1024 + (h >> 2) * 64, PROJ + 1280 + (h >> 2) * 64, 2560, (size_t)b * SEQ, 1, SEQ, qc * 256, p.swa_sink[h] * LOG2E,
                                  Y + h * 64, DM, nullptr, PROJ + 1536 + h * 64, lds);
    }
}

__device__ __forceinline__ void knorm_phase(const Params& p) {
    const bf16_t* PROJ = (const bf16_t*)(p.ws + WS_PROJ); unsigned* KMAX = (unsigned*)(p.ws + WS_KMAX);
    const int tid = tid_opaque(), lane = tid & 63, gw = blockIdx.x * 8 + (tid >> 6);
    float mx = 0.f;
    const int row0 = gw * 16;
    if (row0 < MTOK) {
        for (int j0 = 0; j0 < 16; j0 += 8) {
            u32x4 a[8], b[8];
#pragma unroll
            for (int j = 0; j < 8; ++j) { const bf16_t* kr = PROJ + (size_t)(row0 + j0 + j) * 4096 + 1024 + 16 * lane; a[j] = *(const u32x4*)kr; b[j] = *(const u32x4*)(kr + 8); }
#pragma unroll
            for (int j = 0; j < 8; ++j) { float s = 0.f;
#pragma unroll
                for (int i = 0; i < 4; ++i) { const float x0 = bf_lo(a[j][i]), x1 = bf_hi(a[j][i]), y0 = bf_lo(b[j][i]), y1 = bf_hi(b[j][i]); s += (x0 * x0 + x1 * x1) + (y0 * y0 + y1 * y1); }
                s += swz_xor<1>(s); s += swz_xor<2>(s);
                mx = fmaxf(mx, s); }
        }
        if ((lane & 3) == 0) atomicMax(KMAX + (row0 >> 13) * 16 + (lane >> 2), __float_as_uint(mx));
    }
}

__device__ __forceinline__ int swz16(int row) { return ((row & 3) << 2) | ((row >> 2) & 3); }
__device__ __forceinline__ void diff_attn_phase(const Params& p, LAS unsigned char* lds) {
    constexpr int ld = 4096, NCH = SEQ / 64, STG = 32768;
    const bf16_t* PROJ = (const bf16_t*)(p.ws + WS_PROJ); bf16_t* Y = (bf16_t*)(p.ws + WS_H);
    int tid = threadIdx.x; asm volatile("" : "+v"(tid));
    const int w = __builtin_amdgcn_readfirstlane(tid >> 6), lane = tid & 63, ql = lane & 31, hh = lane >> 5, x32a = ((lane ^ 32) << 2);
    const int comp = w >> 2, wq = w & 3;
    const int pi = (ql & ~12) | ((ql & 4) << 1) | ((ql & 8) >> 1);
    const int swK = swz16(pi);
    const int kbase = pi * 256, kx = ((8 * comp + hh) ^ swK) << 4;
    const int g16 = lane >> 4, i16 = lane & 15, q4 = i16 >> 2, p4 = i16 & 3, cb = g16 & 1;
    const int vb0 = (8 * hh + q4) * 256 + 16 * ((2 * cb + (p4 >> 1)) ^ (2 * hh)) + 8 * (p4 & 1) + 64 * q4;
    const int vb1 = (8 * hh + 4 + q4) * 256 + 16 * ((2 * cb + (p4 >> 1)) ^ (2 * hh + 1)) + 8 * (p4 & 1) + 64 * q4;
    unsigned doff[2]; int dlds[2];
#pragma unroll
    for (int i = 0; i < 2; ++i) { const int Li = tid + 512 * i, row = Li >> 4, chp = Li & 15; doff[i] = (unsigned)(row * ld + ((chp ^ swz16(row)) << 3)) * 2u; dlds[i] = Li * 16; }
    for (int it = blockIdx.x; it < 1024; it += gridDim.x) {
        const int h = it & 7, qc = (it >> 3) & 31, b = it >> 8;
        const size_t tokb = (size_t)b * SEQ;
        const bf16_t* qp = PROJ + h * 128 + 64 * comp; const bf16_t* kp = PROJ + 1024 + h * 128; const bf16_t* vp = PROJ + 2048 + h * 128; const bf16_t* zp = PROJ + 3072 + h * 128;
        const int iw = qc * 256 + 64 * wq;
        bf16x8 qf[2][4];
        int ln0 = lane; asm volatile("" : "+v"(ln0));
#pragma unroll
        for (int r = 0; r < 2; ++r) { const bf16_t* qrow = qp + (tokb + iw + 32 * r + (ln0 & 31)) * ld + 8 * (ln0 >> 5);
#pragma unroll
            for (int ks = 0; ks < 4; ++ks) qf[r][ks] = *(const bf16x8*)(qrow + 16 * ks); }
        f32x16 O[2][4];
#pragma unroll
        for (int r = 0; r < 2; ++r)
#pragma unroll
            for (int t = 0; t < 4; ++t)
#pragma unroll
                for (int i = 0; i < 16; ++i) O[r][t][i] = 0.f;
        float m[2], l[2] = {0.f, 0.f};
        { const float kmx = __uint_as_float(((const unsigned*)(p.ws + WS_KMAX))[b * 16 + h * 2 + comp]);
#pragma unroll
          for (int r = 0; r < 2; ++r) { float s = 0.f;
#pragma unroll
              for (int ks = 0; ks < 4; ++ks) { const u32x4 qv = __builtin_bit_cast(u32x4, qf[r][ks]);
#pragma unroll
                  for (int i = 0; i < 4; ++i) { const float x0 = bf_lo(qv[i]), x1 = bf_hi(qv[i]); s += x0 * x0 + x1 * x1; } }
              m[r] = sqrtf(xsum32(s) * kmx) * 1.001f + 1e-3f; } }
        bf16x8 kone, qm[2];
        { const unsigned one = hh == 0 ? 0x3F80u : 0u; kone = __builtin_bit_cast(bf16x8, (u32x4){one, 0u, 0u, 0u});
#pragma unroll
          for (int r = 0; r < 2; ++r) { const unsigned mb = hh == 0 ? (pk_bf16(-m[r], 0.f) & 0xffffu) : 0u; qm[r] = __builtin_bit_cast(bf16x8, (u32x4){mb, 0u, 0u, 0u}); } }
        auto issue = [&](int ch, int stg) {
            const char* kg = (const char*)(kp + (tokb + 64 * ch) * ld); const char* vg = (const char*)(vp + (tokb + 64 * ch) * ld);
            LAS unsigned char* sb = lds + stg * STG;
#pragma unroll
            for (int i = 0; i < 2; ++i) { unsigned o = doff[i]; asm volatile("" : "+v"(o));
                __builtin_amdgcn_global_load_lds((const void*)(kg + o), (LAS void*)(sb + dlds[i]), 16, 0, 0);
                __builtin_amdgcn_global_load_lds((const void*)(vg + o), (LAS void*)(sb + 16384 + dlds[i]), 16, 0, 0); }
        };
        issue(0, 0); issue(1, 1);
        int s_cur = 0, s_nn = 2;
        for (int ch = 0; ch < NCH; ++ch) {
            if (ch + 1 < NCH) asm volatile("s_waitcnt vmcnt(4)" ::: "memory"); else asm volatile("s_waitcnt vmcnt(0)" ::: "memory");
            __builtin_amdgcn_s_barrier(); asm volatile("" ::: "memory");
            if (ch + 2 < NCH) issue(ch + 2, s_nn);
            const LAS unsigned char* Ksb = lds + s_cur * STG; const LAS unsigned char* Vsb = Ksb + 16384;
            s_nn = s_cur; s_cur = (s_cur == 2) ? 0 : s_cur + 1;
#pragma clang loop unroll(disable)
            for (int u = 0; u < 2; ++u) {
                const LAS unsigned char* Ku = Ksb + u * 8192; const LAS unsigned char* Vu = Vsb + u * 8192;
                int kxl = kx, vb0l = vb0, vb1l = vb1; asm volatile("" : "+v"(kxl), "+v"(vb0l), "+v"(vb1l));
                bf16x8 kf[4];
#pragma unroll
                for (int ks = 0; ks < 4; ++ks) kf[ks] = *(const LAS bf16x8*)(Ku + kbase + (kxl ^ (32 * ks)));
                bf16x8 P[2][2];
#pragma unroll
                for (int r = 0; r < 2; ++r) {
                    f32x16 S;
#pragma unroll
                    for (int i = 0; i < 16; ++i) S[i] = 0.f;
#pragma unroll
                    for (int ks = 0; ks < 4; ++ks) S = __builtin_amdgcn_mfma_f32_32x32x16_bf16(kf[ks], qf[r][ks], S, 0, 0, 0);
                    S = __builtin_amdgcn_mfma_f32_32x32x16_bf16(kone, qm[r], S, 0, 0, 0);
#pragma unroll
                    for (int i = 0; i < 16; ++i) S[i] = __builtin_amdgcn_exp2f(S[i]);
                    l[r] += sum16(S);
                    P[r][0] = pack8(S, 0); P[r][1] = pack8(S, 8);
                }
#pragma unroll
                for (int t = 0; t < 4; ++t) {
                    const LAS unsigned char* a0 = Vu + (vb0l ^ (64 * t)); const LAS unsigned char* a1 = Vu + (vb1l ^ (64 * t));
                    const bf16x8 v0 = tr_pair(a0, a1), v1 = tr_pair(a0 + 4096, a1 + 4096);
                    O[0][t] = __builtin_amdgcn_mfma_f32_32x32x16_bf16(v0, P[0][0], O[0][t], 0, 0, 0);
                    O[1][t] = __builtin_amdgcn_mfma_f32_32x32x16_bf16(v0, P[1][0], O[1][t], 0, 0, 0);
                    O[0][t] = __builtin_amdgcn_mfma_f32_32x32x16_bf16(v1, P[0][1], O[0][t], 0, 0, 0);
                    O[1][t] = __builtin_amdgcn_mfma_f32_32x32x16_bf16(v1, P[1][1], O[1][t], 0, 0, 0);
                }
            }
        }
        int lne = lane; asm volatile("" : "+v"(lne));
        const int hhe = lne >> 5, qle = lne & 31;
        float lam;
        { const float* lv = p.diff_lambda; const float a = lv[lne] * lv[64 + lne], bb = lv[128 + lne] * lv[192 + lne]; const int xa = ((lne ^ 32) << 2); lam = __expf(wave_sum(a, xa)) - __expf(wave_sum(bb, xa)) + p.lam_init; }
#pragma unroll
        for (int r = 0; r < 2; ++r) {
            __builtin_amdgcn_s_barrier(); asm volatile("" ::: "memory");
            LAS float* ex = (LAS float*)lds + wq * 4096 + lne;
            const float lt = xsum32(l[r]);
            if (comp == 1) {
                const float sc = lam / lt;
#pragma unroll
                for (int t = 0; t < 4; ++t)
#pragma unroll
                    for (int i = 0; i < 16; ++i) ex[(t * 16 + i) * 64] = O[r][t][i] * sc;
            }
            asm volatile("s_waitcnt lgkmcnt(0)" ::: "memory"); __builtin_amdgcn_s_barrier(); asm volatile("" ::: "memory");
            if (comp == 0) {
                const float i0 = 1.0f / lt; float ss = 0.f;
#pragma unroll
                for (int t = 0; t < 4; ++t)
#pragma unroll
                    for (int i = 0; i < 16; ++i) { const float a = O[r][t][i] * i0 - ex[(t * 16 + i) * 64]; O[r][t][i] = a; ss += a * a; if (i == 15) __builtin_amdgcn_sched_barrier(0); }
                ss = xsum32(ss);
                const float rn = rsqrtf(ss * (1.0f / 128.0f) + 1e-5f) * p.one_minus_lam_init;
                const unsigned tok = (unsigned)(b * SEQ + iw + 32 * r + qle), zo = tok * (unsigned)ld + 4u * hhe, yo = tok * (unsigned)DM + 4u * hhe;
#pragma unroll
                for (int t = 0; t < 4; ++t)
#pragma unroll
                    for (int i4 = 0; i4 < 4; ++i4) { const int dvc = 32 * t + 8 * i4, dv = dvc + 4 * hhe; const u32x2 z = *(const u32x2*)(zp + (zo + dvc)); const f32x4 sg = *(const f32x4*)(p.diff_subln_g + dv);
                        u32x2 wv; wv.x = pk_bf16(O[r][t][4 * i4] * rn * sg[0] * silu_f(bf_lo(z.x)), O[r][t][4 * i4 + 1] * rn * sg[1] * silu_f(bf_hi(z.x)));
                        wv.y = pk_bf16(O[r][t][4 * i4 + 2] * rn * sg[2] * silu_f(bf_lo(z.y)), O[r][t][4 * i4 + 3] * rn * sg[3] * silu_f(bf_hi(z.y)));
                        *(u32x2*)(Y + h * 128 + (yo + dvc)) = wv; if (i4 == 3) __builtin_amdgcn_sched_barrier(0); }
            }
        }
        __builtin_amdgcn_s_barrier(); asm volatile("" ::: "memory");
    }
}

#define XB_TMO      128
#define XB_XCNT(j)  (256  + 64 * (j))
#define XB_XSUB(j)  (1280 + 64 * (j))
#define XB_XGEN(j)  (2304 + 64 * (j))
#define XB_TOP      3328
#define XB_TOPGEN   3392
#define XCD_BAR_WORDS 3456
#define XB_SPIN_CAP (1u << 18)

__device__ __forceinline__ unsigned xb_ld(unsigned* p)              { return __hip_atomic_load(p, __ATOMIC_RELAXED, __HIP_MEMORY_SCOPE_AGENT); }
__device__ __forceinline__ unsigned xb_add(unsigned* p, unsigned v) { return __hip_atomic_fetch_add(p, v, __ATOMIC_RELAXED, __HIP_MEMORY_SCOPE_AGENT); }
__device__ __forceinline__ unsigned xb_xcc_id() { return (unsigned)__builtin_amdgcn_s_getreg((3 << 11) | 20) & 0xFu; }
#define XB_SPIN(cond, bar) do { unsigned _sp = 0; while (cond) { __builtin_amdgcn_s_sleep(1); \
    if ((++_sp & 255u) == 0u) { if (xb_ld(&(bar)[XB_TMO])) break; if (_sp > XB_SPIN_CAP) { atomicAdd(&(bar)[XB_TMO], 1u); break; } } } } while (0)

struct XcdBarrier {
    unsigned* bar; unsigned x;
    volatile LAS unsigned* st;
};

__device__ __forceinline__ XcdBarrier xcd_barrier_post(unsigned* bar, volatile LAS unsigned* st) {
    XcdBarrier b; b.bar = bar; b.x = xb_xcc_id(); b.st = st;
    if (threadIdx.x == 0) st[2] = xb_add(&bar[XB_XCNT(b.x)], 1u);
    return b;
}
__device__ __forceinline__ void xcd_barrier_complete(unsigned* bar, unsigned x, unsigned& nloc, unsigned& nx) {
    const unsigned G = gridDim.x * gridDim.y * gridDim.z;
    unsigned sum, cnt, mine, sp = 0u;
    for (;;) {
        sum = 0u; cnt = 0u; mine = 0u;
#pragma unroll
        for (unsigned j = 0; j < 16; ++j) { const unsigned c = xb_ld(&bar[XB_XCNT(j)]); sum += c; cnt += (c > 0u) ? 1u : 0u; mine = (j == x) ? c : mine; }
        if (sum == G) break;
        __builtin_amdgcn_s_sleep(1);
        if ((++sp & 255u) == 0u) { if (xb_ld(&bar[XB_TMO])) break; if (sp > XB_SPIN_CAP) { atomicAdd(&bar[XB_TMO], 1u); break; } }
    }
    nloc = mine > 0u ? mine : 1u; nx = cnt > 0u ? cnt : 1u;
}

__device__ __forceinline__ void xcd_barrier(const XcdBarrier& b) {
    asm volatile("s_waitcnt vmcnt(0)" ::: "memory");
    __syncthreads();
    if (threadIdx.x == 0) {
        unsigned* bar = b.bar;
        __builtin_amdgcn_s_waitcnt(0);
        unsigned nloc = b.st[0], nx = b.st[1];
        if (nloc == 0u) { xcd_barrier_complete(bar, b.x, nloc, nx); b.st[0] = nloc; b.st[1] = nx; }
        const unsigned old = xb_add(&bar[XB_XSUB(b.x)], 1u);
        const unsigned gen = old / nloc;
        if (old + 1u == (gen + 1u) * nloc) {
            __builtin_amdgcn_fence(__ATOMIC_RELEASE, "agent");
            asm volatile("s_waitcnt vmcnt(0)" ::: "memory");
            const unsigned og = xb_add(&bar[XB_TOP], 1u);
            const unsigned tg = og / nx;
            if (og + 1u == (tg + 1u) * nx) xb_add(&bar[XB_TOPGEN], 1u);
            else XB_SPIN(xb_ld(&bar[XB_TOPGEN]) == tg, bar);
            __builtin_amdgcn_fence(__ATOMIC_ACQUIRE, "agent");
            xb_add(&bar[XB_XGEN(b.x)], 1u);
            asm volatile("s_waitcnt vmcnt(0)" ::: "memory");
        } else {
            XB_SPIN(xb_ld(&bar[XB_XGEN(b.x)]) == gen, bar);
            __builtin_amdgcn_fence(__ATOMIC_ACQUIRE, "agent");
            asm volatile("s_waitcnt vmcnt(0)" ::: "memory");
        }
    }
    __syncthreads();
}


enum { K_PRO = 0, K_NORM, K_GCONV, K_CONV, K_GOUT, K_GROPE, K_ADIL, K_CDIL, K_ASWA, K_ADIFF, K_FINAL, K_KNORM };
constexpr int NPH = 23;
__constant__ int PH_KIND[NPH] = {K_PRO, K_NORM, K_GCONV, K_CONV, K_GOUT, K_NORM, K_GROPE, K_ADIL, K_CDIL, K_GROPE, K_ADIL, K_CDIL, K_GOUT, K_NORM, K_GROPE, K_ASWA, K_GOUT, K_NORM, K_GROPE, K_KNORM, K_ADIFF, K_GOUT, K_FINAL};
__constant__ int PH_LAYER[NPH] = {0, 0, 0, 0, 0, 1, 1, 1, 1, 1, 1, 1, 1, 2, 2, 2, 2, 3, 3, 3, 3, 3, 0};
__constant__ int PH_HALF[NPH] = {0, 0, 0, 0, 0, 0, 0, 0, 0, 1, 1, 1, 0, 0, 0, 0, 0, 0, 0, 0, 0, 0, 0};

__global__ void __launch_bounds__(512) mega(Params p) {
    extern __shared__ __attribute__((aligned(16))) unsigned char smem[];
    LAS unsigned char* lds = (LAS unsigned char*)smem;
    cg::grid_group grid = cg::this_grid();
    const bf16_t* WT = (const bf16_t*)(p.ws + WS_WT);
    bf16_t* H = (bf16_t*)(p.ws + WS_H); bf16_t* PROJ = (bf16_t*)(p.ws + WS_PROJ);
    const float* MOD = (const float*)(p.ws + WS_MOD);
    volatile LAS unsigned* xst = (volatile LAS unsigned*)(lds + 131072);
    if (threadIdx.x < 4) xst[threadIdx.x] = 0u;
    __syncthreads();
    const XcdBarrier xb = xcd_barrier_post((unsigned*)(p.ws + WS_BAR), xst);
    for (int ph = p.ph_lo; ph < p.ph_hi; ++ph) {
        const int kind = PH_KIND[ph], layer = PH_LAYER[ph], half = PH_HALF[ph];
        int vcu = blockIdx.x;
        { int xo = 131072; asm volatile("" : "+v"(xo));
          volatile LAS unsigned* xs = (volatile LAS unsigned*)(lds + xo);
          const unsigned nloc = xs[0], nx = xs[1], rank = xs[2]; if (nx == 8u && nloc * 8u == gridDim.x && rank < nloc) vcu = (int)(rank * 8u + xb.x); }
        vcu = __builtin_amdgcn_readfirstlane(vcu);
#ifdef DUP_MASK
        for (int rep = 0; rep < (((DUP_MASK) >> kind) & 1 ? 2 : 1); ++rep)
#endif
        switch (kind) {
        case K_PRO: prologue_phase(p, lds); break;
        case K_NORM: norm_phase(p, layer); break;
        case K_GCONV: { EpiConv e; e.out = PROJ; gm::gemm_phase(H, WT + (size_t)WR_CONV_IN * 1024, MTOK, 4096, lds, e, vcu); } break;
        case K_CONV: conv_phase(p); break;
        case K_GOUT: { EpiRes e; e.xin = layer == 0 ? p.x : p.out; e.xout = p.out; e.gate = MOD + (size_t)layer * 4 * 3072 + 2048;
            const int wr = layer == 0 ? WR_CONV_OUT : layer == 1 ? WR_DIL_OUT : layer == 2 ? WR_SWA_OUT : WR_DIFF_OUT;
            gm::gemm_phase(H, WT + (size_t)wr * 1024, MTOK, 1024, lds, e, vcu); } break;
        case K_GROPE: { EpiRope e; e.out = PROJ; int N, wr, M = MTOK; const bf16_t* A = H;
            if (layer == 1) { N = 8192; wr = WR_DIL_IN; M = 16384; A = H + (size_t)half * 16384 * DM; e.ld = 8192; e.rope_end = 6144; e.q_end = 3072; e.hd = 128; e.cosT = (const float*)(p.ws + WS_COS128); e.sinT = (const float*)(p.ws + WS_SIN128); e.qscale = 0.08838834764831845f * LOG2E; }
            else if (layer == 2) { N = 2560; wr = WR_SWA_IN; e.ld = 2560; e.rope_end = 1280; e.q_end = 1024; e.hd = 64; e.cosT = (const float*)(p.ws + WS_COS64); e.sinT = (const float*)(p.ws + WS_SIN64); e.qscale = 0.125f * LOG2E; }
            else { N = 4096; wr = WR_DIFF_IN; e.ld = 4096; e.rope_end = 2048; e.q_end = 1024; e.hd = 64; e.cosT = (const float*)(p.ws + WS_COS64); e.sinT = (const float*)(p.ws + WS_SIN64); e.qscale = 0.125f * LOG2E; }
            gm::gemm_phase(A, WT + (size_t)wr * 1024, M, N, lds, e, vcu); } break;
        case K_ADIL: dil_attn_phase(p, half, lds); break;
        case K_CDIL: dil_combine_phase(p, half); break;
        case K_ASWA: swa_attn_phase(p, lds); break;
        case K_KNORM: knorm_phase(p); break;
        case K_ADIFF: diff_attn_phase(p, lds); break;
        case K_FINAL: final_phase(p); break;
        }
        if (ph + 1 < p.ph_hi) {
            if (p.ph_lo < 0) grid.sync();
            else xcd_barrier(xb);
        }
    }
}

#ifndef N_LAUNCH_PER_PHASE
#define N_LAUNCH_PER_PHASE 0
#endif
extern "C" void kernel_launch(void* const* d_in, const int* in_sizes, int n_in, void* d_out, int out_size, void* d_ws, size_t ws_size, hipStream_t stream) {
    constexpr int LDS_BYTES = 131072 + 16;
    static int grid = 0;
    if (grid == 0) {
        if (n_in != 18 || out_size != MTOK * DM || ws_size < WS_END) { fprintf(stderr, "kernel_launch: unexpected shapes n_in %d out %d ws %zu\n", n_in, out_size, ws_size); grid = -1; return; }
        int dev = 0, cus = 0, per_cu = 0;
        hipGetDevice(&dev); hipDeviceGetAttribute(&cus, hipDeviceAttributeMultiprocessorCount, dev);
        if (hipFuncSetAttribute((const void*)mega, hipFuncAttributeMaxDynamicSharedMemorySize, LDS_BYTES) != hipSuccess) { fprintf(stderr, "hipFuncSetAttribute failed\n"); grid = -1; return; }
        hipOccupancyMaxActiveBlocksPerMultiprocessor(&per_cu, (const void*)mega, 512, LDS_BYTES);
        if (per_cu < 1) { fprintf(stderr, "occupancy query says %d blocks per CU\n", per_cu); }
        (void)hipGetLastError();
        grid = cus;
    }
    if (grid < 0) return;
    if (hipMemsetAsync(d_ws, 0, 16384, stream) != hipSuccess) { fprintf(stderr, "memset of barrier words failed\n"); return; }
    Params p{};
    p.x = (const float*)d_in[0]; p.c = (const float*)d_in[1]; p.norm_g = (const float*)d_in[2]; p.w_mod = (const float*)d_in[3]; p.b_mod = (const float*)d_in[4];
    p.conv_w_in = (const float*)d_in[5]; p.conv_k = (const float*)d_in[6]; p.conv_w_out = (const float*)d_in[7];
    p.dil_w_in = (const float*)d_in[8]; p.dil_w_out = (const float*)d_in[9];
    p.swa_w_in = (const float*)d_in[10]; p.swa_sink = (const float*)d_in[11]; p.swa_w_out = (const float*)d_in[12];
    p.diff_w_in = (const float*)d_in[13]; p.diff_lambda = (const float*)d_in[14]; p.diff_subln_g = (const float*)d_in[15]; p.diff_w_out = (const float*)d_in[16];
    p.final_g = (const float*)d_in[17];
    p.out = (float*)d_out; p.ws = (unsigned char*)d_ws;
    for (int i = 0; i < 64; ++i) p.inv128[i] = (float)std::pow(10000.0, -(double)(2 * i) / 128.0);
    for (int i = 0; i < 32; ++i) p.inv64[i] = (float)std::pow(10000.0, -(double)(2 * i) / 64.0);
    p.lam_init = (float)(0.8 - 0.6 * std::exp(-0.3 * 3.0)); p.one_minus_lam_init = 1.0f - p.lam_init;
#if N_LAUNCH_PER_PHASE
    for (int ph = 0; ph < NPH; ++ph) {
        p.ph_lo = ph; p.ph_hi = ph + 1;
        void* args[] = {&p};
        hipError_t e = hipLaunchCooperativeKernel((const void*)mega, dim3(grid), dim3(512), args, LDS_BYTES, stream);
        if (e != hipSuccess) { fprintf(stderr, "cooperative launch failed: %s (grid %d)\n", hipGetErrorString(e), grid); break; }
    }
#else
    p.ph_lo = 0; p.ph_hi = NPH;
    void* args[] = {&p};
    hipError_t e = hipLaunchCooperativeKernel((const void*)mega, dim3(grid), dim3(512), args, LDS_BYTES, stream);
    if (e != hipSuccess) fprintf(stderr, "cooperative launch failed: %s (grid %d)\n", hipGetErrorString(e), grid);
#endif
}
```

```cpp
#include <hip/hip_runtime.h>
#include <hip/hip_cooperative_groups.h>
#include <cstdio>
#include <cstdint>
#include <cmath>
namespace cg = cooperative_groups;

#define LAS __attribute__((address_space(3)))
typedef unsigned short bf16_t;
typedef short bf16x8 __attribute__((ext_vector_type(8)));
typedef short s16x4 __attribute__((ext_vector_type(4)));
typedef float f32x4 __attribute__((ext_vector_type(4)));
typedef float f32x16 __attribute__((ext_vector_type(16)));
typedef unsigned u32x4 __attribute__((ext_vector_type(4)));
typedef unsigned u32x2 __attribute__((ext_vector_type(2)));

constexpr int DM = 1024, NB = 4, SEQ = 8192, MTOK = NB * SEQ;
constexpr float LOG2E = 1.4426950408889634f;

constexpr size_t MiB = 1024ull * 1024ull;
constexpr size_t WS_BAR = 0;
constexpr size_t WS_KMAX = 14336;
constexpr size_t WS_MOD = 16384;
constexpr size_t WS_COS128 = 1 * MiB;
constexpr size_t WS_SIN128 = 3 * MiB;
constexpr size_t WS_COS64 = 5 * MiB;
constexpr size_t WS_SIN64 = 6 * MiB;
constexpr size_t WS_WT = 7 * MiB;
constexpr size_t WS_H = 52 * MiB;
constexpr size_t WS_OG = 116 * MiB;
constexpr size_t WS_LSE = 212 * MiB;
constexpr size_t WS_PROJ = 214 * MiB;
constexpr size_t WS_END = 470 * MiB;
constexpr int WR_CONV_IN = 0, WR_CONV_OUT = 4096, WR_DIL_IN = 5120, WR_DIL_OUT = 13312, WR_SWA_IN = 14336, WR_SWA_OUT = 16896, WR_DIFF_IN = 17920, WR_DIFF_OUT = 22016;

struct Params {
    const float* x; const float* c; const float* norm_g; const float* w_mod; const float* b_mod;
    const float* conv_w_in; const float* conv_k; const float* conv_w_out;
    const float* dil_w_in; const float* dil_w_out;
    const float* swa_w_in; const float* swa_sink; const float* swa_w_out;
    const float* diff_w_in; const float* diff_lambda; const float* diff_subln_g; const float* diff_w_out;
    const float* final_g;
    float* out; unsigned char* ws;
    float inv128[64]; float inv64[32];
    float lam_init; int ph_lo; int ph_hi; float one_minus_lam_init;
};

typedef __bf16 bf16v2 __attribute__((ext_vector_type(2)));
typedef float f32x2 __attribute__((ext_vector_type(2)));
__device__ __forceinline__ unsigned pk_bf16(float lo, float hi) { const f32x2 v = {lo, hi}; const bf16v2 b = __builtin_convertvector(v, bf16v2); return __builtin_bit_cast(unsigned, b); }
__device__ __forceinline__ float bf_lo(unsigned u) { return __uint_as_float(u << 16); }
__device__ __forceinline__ float bf_hi(unsigned u) { return __uint_as_float(u & 0xffff0000u); }
__device__ __forceinline__ float silu_f(float v) { return v * __builtin_amdgcn_rcpf(1.0f + __builtin_amdgcn_exp2f(-LOG2E * v)); }
__device__ __forceinline__ int tid_opaque() { int t = threadIdx.x; asm volatile("" : "+v"(t)); return t; }
template <int X> __device__ __forceinline__ float swz_xor(float v) { return __int_as_float(__builtin_amdgcn_ds_swizzle(__float_as_int(v), 0x1f | (X << 10))); }
__device__ __forceinline__ float xor32(float v, int x32a) { return __int_as_float(__builtin_amdgcn_ds_bpermute(x32a, __float_as_int(v))); }
__device__ __forceinline__ float wave_sum(float v, int x32a) {
    v += swz_xor<1>(v); v += swz_xor<2>(v); v += swz_xor<4>(v); v += swz_xor<8>(v); v += swz_xor<16>(v); v += xor32(v, x32a);
    return v;
}

namespace gm {
constexpr int BM = 256, BK = 64, HALF = 128, HTB = HALF * BK * 2, KD = 1024, NT = KD / BK, NXCD = 8, WGM = 8;
__device__ __forceinline__ void stage_rc(int b, int& R, int& C) { const int st = b / 1024, sb = b % 1024, swz = sb ^ (((sb >> 9) & 1) << 5); R = (st >> 1) * 16 + swz / 64; C = (st & 1) * 32 + (swz % 64) / 2; }

#define GM_WAIT_V(n) asm volatile("s_waitcnt vmcnt(" #n ")" ::: "memory")
#define GM_WAIT_L(n) asm volatile("s_waitcnt lgkmcnt(" #n ")" ::: "memory")
#define GM_BAR __builtin_amdgcn_s_barrier()
#define GM_SCHED __builtin_amdgcn_sched_barrier(0)

template <class Epi>
__device__ __forceinline__ void gemm_phase(const bf16_t* __restrict__ A, const bf16_t* __restrict__ Bt, int M, int N, LAS unsigned char* lds, const Epi& epi, int vcu) {
    int tid = threadIdx.x; asm volatile("" : "+v"(tid));
    const int wid = tid >> 6, lane = tid & 63, wr = __builtin_amdgcn_readfirstlane(wid >> 2), wc = __builtin_amdgcn_readfirstlane(wid & 3), fr = lane & 15, fq = lane >> 4;
    int sr0, sc0, sr1, sc1; stage_rc(tid * 16, sr0, sc0); stage_rc(tid * 16 + 8192, sr1, sc1);
    const unsigned soff0 = (unsigned)(sr0 * KD + sc0) * 2u, soff1 = (unsigned)(sr1 * KD + sc1) * 2u;
    const int ob = fr * 64 + fq * 16, obs = ob ^ (((ob >> 9) & 1) << 5);
    const int aoff = wr * 8192 + obs, boff = wc * 4096 + obs;
    const int nM = M / BM, nN = N / BM, nwg = nM * nN;
#define GM_SA(b, h) (lds + ((b) * 2 + (h)) * HTB)
#define GM_SB(b, h) (lds + (4 + (b) * 2 + (h)) * HTB)
#define GM_STAGE(P, BASE, br, kt) do { const char* _g = (const char*)((BASE) + (size_t)(br) * KD + (kt) * BK); \
        unsigned _o0 = soff0, _o1 = soff1; asm volatile("" : "+v"(_o0), "+v"(_o1)); \
        __builtin_amdgcn_global_load_lds((const void*)(_g + _o0), (LAS void*)((P) + tid * 16), 16, 0, 0); \
        __builtin_amdgcn_global_load_lds((const void*)(_g + _o1), (LAS void*)((P) + tid * 16 + 8192), 16, 0, 0); } while (0)
#define GM_LDA(dst, b, h) _Pragma("unroll") for (int m = 0; m < 4; ++m) _Pragma("unroll") for (int k = 0; k < 2; ++k) \
        dst[m][k] = *(const LAS bf16x8*)(GM_SA(b, h) + aoff + (m * 2 + k) * 1024)
#define GM_LDB(dst, b, h) _Pragma("unroll") for (int n = 0; n < 2; ++n) _Pragma("unroll") for (int k = 0; k < 2; ++k) \
        dst[n][k] = *(const LAS bf16x8*)(GM_SB(b, h) + boff + (n * 2 + k) * 1024)
#define GM_MMA(ai, bj, At, Bv) do { __builtin_amdgcn_s_setprio(1); \
        _Pragma("unroll") for (int m = 0; m < 4; ++m) _Pragma("unroll") for (int n = 0; n < 2; ++n) _Pragma("unroll") for (int k = 0; k < 2; ++k) \
            acc[ai][bj][m][n] = __builtin_amdgcn_mfma_f32_16x16x32_bf16(Bv[n][k], At[m][k], acc[ai][bj][m][n], 0, 0, 0); \
        __builtin_amdgcn_s_setprio(0); } while (0)
    auto tile_rc = [&](int it, int& brow, int& bcol) -> bool {
        const long Lq = (long)it * gridDim.x + vcu; if (Lq >= nwg) return false;
        int wgid = (int)Lq; { const int q = nwg / NXCD, r = nwg % NXCD, xcd = wgid % NXCD, off = wgid / NXCD; wgid = (xcd < r ? xcd * (q + 1) : r * (q + 1) + (xcd - r) * q) + off; }
        const int nig = WGM * nN, gid = wgid / nig, fm = gid * WGM, gsz = (nM - fm) < WGM ? (nM - fm) : WGM;
        brow = (fm + ((wgid % nig) % gsz)) * BM; bcol = ((wgid % nig) / gsz) * BM; return true;
    };
    int brow = 0, bcol = 0;
    if (!tile_rc(0, brow, bcol)) return;
    GM_STAGE(GM_SB(0, 0), Bt, bcol, 0); GM_STAGE(GM_SA(0, 0), A, brow, 0); GM_STAGE(GM_SB(0, 1), Bt, bcol + HALF, 0); GM_STAGE(GM_SA(0, 1), A, brow + HALF, 0);
    if (wr == 1) GM_BAR;
    GM_WAIT_V(4); GM_BAR;
    GM_STAGE(GM_SB(1, 0), Bt, bcol, 1); GM_STAGE(GM_SA(1, 0), A, brow, 1); GM_STAGE(GM_SB(1, 1), Bt, bcol + HALF, 1);
    GM_WAIT_V(6); GM_BAR;
    for (int it = 0;; ++it) {
        int nrow = brow, ncol = bcol;
        const bool have_next = tile_rc(it + 1, nrow, ncol);
        f32x4 acc[2][2][4][2];
#pragma unroll
        for (int a = 0; a < 2; ++a)
#pragma unroll
            for (int b = 0; b < 2; ++b)
#pragma unroll
                for (int m = 0; m < 4; ++m)
#pragma unroll
                    for (int n = 0; n < 2; ++n) acc[a][b][m][n] = (f32x4){0.f, 0.f, 0.f, 0.f};
        bf16x8 At[4][2], B0[2][2], B1[2][2];
        for (int t = 0; t < NT; t += 2) {
            const bool lastk = (t + 2 >= NT);
            const int prow = lastk ? nrow : brow, pcol = lastk ? ncol : bcol, k2 = lastk ? 0 : t + 2, k3 = lastk ? 1 : t + 3;
            GM_LDB(B0, 0, 0); GM_SCHED; GM_LDA(At, 0, 0); GM_STAGE(GM_SA(1, 1), A, brow + HALF, t + 1);
            GM_WAIT_L(8); GM_BAR; GM_WAIT_L(0); GM_MMA(0, 0, At, B0); GM_BAR; GM_SCHED;
            GM_LDB(B1, 0, 1); GM_STAGE(GM_SB(0, 0), Bt, pcol, k2);
            GM_BAR; GM_WAIT_L(0); GM_MMA(0, 1, At, B1); GM_BAR;
            GM_LDA(At, 0, 1); GM_STAGE(GM_SA(0, 0), A, prow, k2);
            GM_BAR; GM_WAIT_L(0); GM_MMA(1, 0, At, B0); GM_BAR; GM_SCHED;
            GM_STAGE(GM_SB(0, 1), Bt, pcol + HALF, k2);
            GM_WAIT_V(6); GM_BAR; GM_MMA(1, 1, At, B1); GM_BAR;
            GM_LDB(B0, 1, 0); GM_SCHED; GM_LDA(At, 1, 0); GM_STAGE(GM_SA(0, 1), A, prow + HALF, k2);
            GM_WAIT_L(8); GM_BAR; GM_WAIT_L(0); GM_MMA(0, 0, At, B0); GM_BAR; GM_SCHED;
            GM_LDB(B1, 1, 1); GM_STAGE(GM_SB(1, 0), Bt, pcol, k3);
            GM_BAR; GM_WAIT_L(0); GM_MMA(0, 1, At, B1); GM_BAR;
            GM_LDA(At, 1, 1); GM_STAGE(GM_SA(1, 0), A, prow, k3);
            GM_BAR; GM_WAIT_L(0); GM_MMA(1, 0, At, B0); GM_BAR; GM_SCHED;
            GM_STAGE(GM_SB(1, 1), Bt, pcol + HALF, k3);
            GM_WAIT_V(6); GM_BAR; GM_MMA(1, 1, At, B1); GM_BAR;
        }
        {
        int fre = fr, fqe = fq; asm volatile("" : "+v"(fre), "+v"(fqe));
#pragma unroll
        for (int ai = 0; ai < 2; ++ai)
#pragma unroll
            for (int mp = 0; mp < 2; ++mp) {
#pragma unroll
                for (int mq = 0; mq < 2; ++mq)
#pragma unroll
                    for (int bj = 0; bj < 2; ++bj) { const int m = mp * 2 + mq;
                        epi(brow + ai * HALF + wr * 64 + m * 16 + fre, (bcol + bj * HALF + wc * 32) >> 5, fqe, acc[ai][bj][m][0], acc[ai][bj][m][1]); }
                GM_SCHED;
            }
        }
        if (!have_next) break;
        brow = nrow; bcol = ncol;
    }
    GM_WAIT_V(0);
    if (wr == 0) GM_BAR;
}
}

struct EpiRope {
    bf16_t* out; int ld; int rope_end; int q_end; int hd; const float* cosT; const float* sinT; float qscale;
    __device__ __forceinline__ void operator()(int row, int G, int fq, f32x4 v0, f32x4 v1) const {
        const int col32 = G * 32;
        const unsigned ro = (unsigned)row * (unsigned)ld;
        if (col32 < rope_end) {
            const int half = hd >> 1, hb = col32 & ~(hd - 1), d0 = ((col32 & (hd - 1)) >> 5) * 16 + fq * 4, pos = row & (SEQ - 1);
            const unsigned to = (unsigned)(pos * half + d0);
            const f32x4 c = *(const f32x4*)(cosT + to), s = *(const f32x4*)(sinT + to);
            const f32x4 o1 = v0 * c - v1 * s, o2 = v1 * c + v0 * s;
            u32x2 w1, w2; w1.x = pk_bf16(o1[0], o1[1]); w1.y = pk_bf16(o1[2], o1[3]); w2.x = pk_bf16(o2[0], o2[1]); w2.y = pk_bf16(o2[2], o2[3]);
            *(u32x2*)(out + (ro + (unsigned)(hb + d0))) = w1; *(u32x2*)(out + (ro + (unsigned)(hb + half + d0))) = w2;
        } else {
            u32x4 w; w.x = pk_bf16(v0[0], v0[1]); w.y = pk_bf16(v0[2], v0[3]); w.z = pk_bf16(v1[0], v1[1]); w.w = pk_bf16(v1[2], v1[3]);
            *(u32x4*)(out + (ro + (unsigned)(col32 + 8 * fq))) = w;
        }
    }
};
struct EpiConv {
    bf16_t* out;
    __device__ __forceinline__ void operator()(int row, int G, int fq, f32x4 v0, f32x4 v1) const {
        f32x4 r;
        if (G < 64) r = v0 * v1;
        else { r[0] = v0[0] * silu_f(v1[0]); r[1] = v0[1] * silu_f(v1[1]); r[2] = v0[2] * silu_f(v1[2]); r[3] = v0[3] * silu_f(v1[3]); }
        u32x2 w; w.x = pk_bf16(r[0], r[1]); w.y = pk_bf16(r[2], r[3]);
        *(u32x2*)(out + ((unsigned)row * 2048u + (unsigned)(G * 16 + 4 * fq))) = w;
    }
};
struct EpiRes {
    const float* xin; float* xout; const float* gate;
    __device__ __forceinline__ void operator()(int row, int G, int fq, f32x4 v0, f32x4 v1) const {
        const int col = G * 32 + 8 * fq, b = row >> 13;
        const unsigned xo = (unsigned)row * (unsigned)DM + (unsigned)col;
        const float* gp = gate + (unsigned)(b * 3072 + col); const float* xp = xin + xo; float* op = xout + xo;
        const f32x4 g0 = *(const f32x4*)gp, g1 = *(const f32x4*)(gp + 4), x0 = *(const f32x4*)xp, x1 = *(const f32x4*)(xp + 4);
        *(f32x4*)op = x0 + g0 * v0; *(f32x4*)(op + 4) = x1 + g1 * v1;
    }
};

__device__ __forceinline__ int srccol(int kind, int rope_end, int n) {
    if (kind == 1) { const int G = n >> 5, nn = (n >> 4) & 1, i = n & 15; return G < 64 ? (nn ? 2048 : 1024) + 16 * G + i : (nn ? 3072 : 0) + 16 * (G - 64) + i; }
    if (kind >= 2 && n < rope_end) { const int hd = kind == 2 ? 128 : 64; const int hb = n & ~(hd - 1), r = n & (hd - 1), gg = r >> 5, nn = (r >> 4) & 1, i = r & 15; return hb + (hd >> 1) * nn + 16 * gg + i; }
    return (n & ~31) | (((n >> 2) & 3) << 3) | (((n >> 4) & 1) << 2) | (n & 3);
}
__device__ __forceinline__ void transpose_item(const float* __restrict__ W, int N, int kind, int rope_end, bf16_t* __restrict__ WT, int n0, int k0, LAS unsigned char* lds, int q_end, float qscale) {
    LAS bf16_t* tile = (LAS bf16_t*)lds;
    const int t = tid_opaque(), kk = t >> 4, nn4 = (t & 15) * 4;
    const int src = srccol(kind, rope_end, n0 + nn4);
    const float wsc = (n0 + nn4 < q_end) ? qscale : 1.0f;
    f32x4 w[8];
#pragma unroll
    for (int i = 0; i < 8; ++i) w[i] = *(const f32x4*)(W + (size_t)(k0 + kk + 32 * i) * N + src);
#pragma unroll
    for (int i = 0; i < 8; ++i) { const int k = kk + 32 * i; const f32x4 v = w[i] * wsc;
        const unsigned a = pk_bf16(v[0], v[1]), b = pk_bf16(v[2], v[3]);
        tile[(nn4 + 0) * 264 + k] = (bf16_t)(a & 0xffff); tile[(nn4 + 1) * 264 + k] = (bf16_t)(a >> 16); tile[(nn4 + 2) * 264 + k] = (bf16_t)(b & 0xffff); tile[(nn4 + 3) * 264 + k] = (bf16_t)(b >> 16); }
    __syncthreads();
#pragma unroll
    for (int i = 0; i < 4; ++i) { const int idx = t + 512 * i, n = idx >> 5, kc = (idx & 31) * 8; const u32x4 v = *(const LAS u32x4*)(tile + n * 264 + kc); *(u32x4*)(WT + (size_t)(n0 + n) * 1024 + k0 + kc) = v; }
    __syncthreads();
}
__device__ __forceinline__ void mod_item(const Params& p, int layer, int cc, LAS unsigned char* lds) {
    LAS float* sc = (LAS float*)lds;
    LAS float* red = (LAS float*)(lds + 16384);
    const int t = tid_opaque(), w = t >> 6, lane = t & 63;
#pragma unroll
    for (int i = 0; i < 8; ++i) { const int idx = t + 512 * i; sc[idx] = silu_f(p.c[idx]); }
    __syncthreads();
    const float* W = p.w_mod + (size_t)layer * DM * 3072 + cc * 64 + lane;
    float a0 = 0.f, a1 = 0.f, a2 = 0.f, a3 = 0.f;
#pragma unroll 8
    for (int kk = 0; kk < 128; ++kk) { const int k = w * 128 + kk; const float wv = W[(size_t)k * 3072];
        a0 += sc[k] * wv; a1 += sc[1024 + k] * wv; a2 += sc[2048 + k] * wv; a3 += sc[3072 + k] * wv; }
    red[(w * 4 + 0) * 64 + lane] = a0; red[(w * 4 + 1) * 64 + lane] = a1; red[(w * 4 + 2) * 64 + lane] = a2; red[(w * 4 + 3) * 64 + lane] = a3;
    __syncthreads();
    if (t < 256) { const int b = t >> 6, col = t & 63; float s = 0.f;
#pragma unroll
        for (int ww = 0; ww < 8; ++ww) s += red[(ww * 4 + b) * 64 + col];
        ((float*)(p.ws + WS_MOD))[((size_t)layer * 4 + b) * 3072 + cc * 64 + col] = s + p.b_mod[layer * 3072 + cc * 64 + col]; }
    __syncthreads();
}
__device__ __forceinline__ void sincos_d(double a, float& c, float& s) {
    const double TWO_PI = 6.283185307179586476925286766559, INV_TWO_PI = 0.15915494309189533576888376337251;
    const double k = __builtin_rint(a * INV_TWO_PI); const double r = a - k * TWO_PI, r2 = r * r;
    double tc = 1.0, sumc = 1.0, ts = r, sums = r;
#pragma unroll
    for (int n = 1; n <= 13; ++n) { tc = -tc * r2 * (1.0 / (double)((2 * n - 1) * (2 * n))); sumc += tc; ts = -ts * r2 * (1.0 / (double)((2 * n) * (2 * n + 1))); sums += ts; }
    c = (float)sumc; s = (float)sums;
}
__device__ __forceinline__ void prologue_phase(const Params& p, LAS unsigned char* lds) {
    constexpr int T_ITEMS = 1440, M_ITEMS = 192, R_ITEMS = 1536;
    bf16_t* WT = (bf16_t*)(p.ws + WS_WT);
    for (int it = blockIdx.x; it < T_ITEMS + M_ITEMS + R_ITEMS; it += gridDim.x) {
        if (it < M_ITEMS) { mod_item(p, it / 48, it % 48, lds); continue; }
        int r = it - M_ITEMS;
        if (r < T_ITEMS) {
            const float* W; int N, kind, rope_end, wr, q_end = 0; float qs = 1.0f;
            if (r < 256) { W = p.conv_w_in; N = 4096; kind = 1; rope_end = 0; wr = WR_CONV_IN; }
            else if ((r -= 256) < 64) { W = p.conv_w_out; N = 1024; kind = 0; rope_end = 0; wr = WR_CONV_OUT; }
            else if ((r -= 64) < 512) { W = p.dil_w_in; N = 8192; kind = 2; rope_end = 6144; wr = WR_DIL_IN; q_end = 3072; qs = 0.08838834764831845f * LOG2E; }
            else if ((r -= 512) < 64) { W = p.dil_w_out; N = 1024; kind = 0; rope_end = 0; wr = WR_DIL_OUT; }
            else if ((r -= 64) < 160) { W = p.swa_w_in; N = 2560; kind = 3; rope_end = 1280; wr = WR_SWA_IN; q_end = 1024; qs = 0.125f * LOG2E; }
            else if ((r -= 160) < 64) { W = p.swa_w_out; N = 1024; kind = 0; rope_end = 0; wr = WR_SWA_OUT; }
            else if ((r -= 64) < 256) { W = p.diff_w_in; N = 4096; kind = 3; rope_end = 2048; wr = WR_DIFF_IN; q_end = 1024; qs = 0.125f * LOG2E; }
            else { r -= 256; W = p.diff_w_out; N = 1024; kind = 0; rope_end = 0; wr = WR_DIFF_OUT; }
            const int ntile = r >> 2, ktile = r & 3;
            transpose_item(W, N, kind, rope_end, WT + (size_t)wr * 1024, ntile * 64, ktile * 256, lds, q_end, qs);
            continue;
        }
        r -= T_ITEMS;
        const int idx = r * 512 + tid_opaque();
        if (idx < SEQ * 64) { const int pos = idx >> 6, i = idx & 63; const float ang = (float)pos * p.inv128[i]; float c, s; sincos_d((double)ang, c, s);
            ((float*)(p.ws + WS_COS128))[idx] = c; ((float*)(p.ws + WS_SIN128))[idx] = s; }
        else { const int j = idx - SEQ * 64, pos = j >> 5, i = j & 31; const float ang = (float)pos * p.inv64[i]; float c, s; sincos_d((double)ang, c, s);
            ((float*)(p.ws + WS_COS64))[j] = c; ((float*)(p.ws + WS_SIN64))[j] = s; }
    }
}

__device__ __forceinline__ void norm_phase(const Params& p, int layer) {
    const float* src = layer == 0 ? p.x : p.out; const float* g = p.norm_g + layer * DM; const float* mod = (const float*)(p.ws + WS_MOD) + (size_t)layer * 4 * 3072;
    bf16_t* H = (bf16_t*)(p.ws + WS_H);
    const int tid = tid_opaque(), lane = tid & 63, gw = blockIdx.x * 8 + (tid >> 6), ngw = gridDim.x * 8, x32a = ((lane ^ 32) << 2);
    constexpr int RPW = 16;
    for (int r0 = gw * RPW; r0 < MTOK; r0 += ngw * RPW) {
        const float* mb = mod + (r0 >> 13) * 3072;
        f32x4 gs[4], sh[4];
#pragma unroll
        for (int j = 0; j < 4; ++j) { const int col = 4 * lane + 256 * j; gs[j] = *(const f32x4*)(g + col) * (*(const f32x4*)(mb + 1024 + col) + 1.0f); sh[j] = *(const f32x4*)(mb + col); }
        for (int rr = 0; rr < RPW; rr += 2) {
            const int row = r0 + rr;
            const f32x4* xa = (const f32x4*)(src + (size_t)row * DM) + lane; const f32x4* xb = xa + DM / 4;
            f32x4 va[4], vb[4]; float sa = 0.f, sb = 0.f;
#pragma unroll
            for (int j = 0; j < 4; ++j) { va[j] = xa[64 * j]; vb[j] = xb[64 * j]; }
#pragma unroll
            for (int j = 0; j < 4; ++j) { sa += (va[j][0] * va[j][0] + va[j][1] * va[j][1]) + (va[j][2] * va[j][2] + va[j][3] * va[j][3]); sb += (vb[j][0] * vb[j][0] + vb[j][1] * vb[j][1]) + (vb[j][2] * vb[j][2] + vb[j][3] * vb[j][3]); }
            const float ra = rsqrtf(wave_sum(sa, x32a) * (1.0f / DM) + 1e-6f), rb = rsqrtf(wave_sum(sb, x32a) * (1.0f / DM) + 1e-6f);
#pragma unroll
            for (int j = 0; j < 4; ++j) { const int col = 4 * lane + 256 * j;
                const f32x4 ya = (va[j] * ra) * gs[j] + sh[j], yb = (vb[j] * rb) * gs[j] + sh[j];
                u32x2 wa, wb; wa.x = pk_bf16(ya[0], ya[1]); wa.y = pk_bf16(ya[2], ya[3]); wb.x = pk_bf16(yb[0], yb[1]); wb.y = pk_bf16(yb[2], yb[3]);
                *(u32x2*)(H + (size_t)row * DM + col) = wa; *(u32x2*)(H + (size_t)(row + 1) * DM + col) = wb; }
        }
    }
}
__device__ __forceinline__ void final_phase(const Params& p) {
    const int tid = tid_opaque(), lane = tid & 63, gw = blockIdx.x * 8 + (tid >> 6), ngw = gridDim.x * 8, x32a = ((lane ^ 32) << 2);
    constexpr int RPW = 16;
    f32x4 gg[4];
#pragma unroll
    for (int j = 0; j < 4; ++j) gg[j] = *(const f32x4*)(p.final_g + 4 * lane + 256 * j);
    for (int r0 = gw * RPW; r0 < MTOK; r0 += ngw * RPW) {
        for (int rr = 0; rr < RPW; rr += 2) {
            f32x4* xa = (f32x4*)(p.out + (size_t)(r0 + rr) * DM) + lane; f32x4* xb = xa + DM / 4;
            f32x4 va[4], vb[4]; float sa = 0.f, sb = 0.f;
#pragma unroll
            for (int j = 0; j < 4; ++j) { va[j] = xa[64 * j]; vb[j] = xb[64 * j]; }
#pragma unroll
            for (int j = 0; j < 4; ++j) { sa += (va[j][0] * va[j][0] + va[j][1] * va[j][1]) + (va[j][2] * va[j][2] + va[j][3] * va[j][3]); sb += (vb[j][0] * vb[j][0] + vb[j][1] * vb[j][1]) + (vb[j][2] * vb[j][2] + vb[j][3] * vb[j][3]); }
            const float ra = rsqrtf(wave_sum(sa, x32a) * (1.0f / DM) + 1e-6f), rb = rsqrtf(wave_sum(sb, x32a) * (1.0f / DM) + 1e-6f);
#pragma unroll
            for (int j = 0; j < 4; ++j) { xa[64 * j] = (va[j] * ra) * gg[j]; xb[64 * j] = (vb[j] * rb) * gg[j]; }
        }
    }
}
__device__ __forceinline__ void conv_phase(const Params& p) {
    const bf16_t* TU = (const bf16_t*)(p.ws + WS_PROJ); bf16_t* Y = (bf16_t*)(p.ws + WS_H);
    const int nth = gridDim.x * 512;
    for (int idx = blockIdx.x * 512 + tid_opaque(); idx < MTOK * 128; idx += nth) {
        const int row = idx >> 7, e = (idx & 127) * 8, s = row & (SEQ - 1);
        const bf16_t* tp = TU + (size_t)row * 2048 + e;
        const u32x4 t1 = *(const u32x4*)tp, uu = *(const u32x4*)(tp + 1024);
        u32x4 t0 = (u32x4){0, 0, 0, 0}, t2 = (u32x4){0, 0, 0, 0};
        if (s > 0) t0 = *(const u32x4*)(tp - 2048);
        if (s < SEQ - 1) t2 = *(const u32x4*)(tp + 2048);
        const f32x4 k0a = *(const f32x4*)(p.conv_k + e), k0b = *(const f32x4*)(p.conv_k + e + 4), k1a = *(const f32x4*)(p.conv_k + 1024 + e), k1b = *(const f32x4*)(p.conv_k + 1024 + e + 4),
                    k2a = *(const f32x4*)(p.conv_k + 2048 + e), k2b = *(const f32x4*)(p.conv_k + 2048 + e + 4);
        u32x4 o;
#pragma unroll
        for (int j = 0; j < 4; ++j) {
            const float ka0 = j < 2 ? k0a[2 * j] : k0b[2 * j - 4], kb0 = j < 2 ? k0a[2 * j + 1] : k0b[2 * j - 3];
            const float ka1 = j < 2 ? k1a[2 * j] : k1b[2 * j - 4], kb1 = j < 2 ? k1a[2 * j + 1] : k1b[2 * j - 3];
            const float ka2 = j < 2 ? k2a[2 * j] : k2b[2 * j - 4], kb2 = j < 2 ? k2a[2 * j + 1] : k2b[2 * j - 3];
            const float lo = bf_lo(uu[j]) * (ka0 * bf_lo(t0[j]) + ka1 * bf_lo(t1[j]) + ka2 * bf_lo(t2[j]));
            const float hi = bf_hi(uu[j]) * (kb0 * bf_hi(t0[j]) + kb1 * bf_hi(t1[j]) + kb2 * bf_hi(t2[j]));
            o[j] = pk_bf16(lo, hi);
        }
        *(u32x4*)(Y + (size_t)row * DM + e) = o;
    }
}
__device__ __forceinline__ void dil_combine_phase(const Params& p, int half) {
    const bf16_t* OG = (const bf16_t*)(p.ws + WS_OG); const float* LSE = (const float*)(p.ws + WS_LSE); const bf16_t* PROJ = (const bf16_t*)(p.ws + WS_PROJ);
    bf16_t* Y = (bf16_t*)(p.ws + WS_H) + (size_t)half * 16384 * DM;
    const int nth = gridDim.x * 512;
    for (int idx = blockIdx.x * 512 + tid_opaque(); idx < 16384 * 128; idx += nth) {
        const int row = idx >> 7, e = (idx & 127) * 8, h = e >> 7;
        const float l0 = LSE[(size_t)row * 8 + h], l1 = LSE[(size_t)(16384 + row) * 8 + h], l2 = LSE[(size_t)(32768 + row) * 8 + h];
        const float mx = fmaxf(l0, fmaxf(l1, l2)); float w0 = __builtin_amdgcn_exp2f(l0 - mx), w1 = __builtin_amdgcn_exp2f(l1 - mx), w2 = __builtin_amdgcn_exp2f(l2 - mx);
        const float inv = 1.0f / (w0 + w1 + w2); w0 *= inv; w1 *= inv; w2 *= inv;
        const u32x4 a = *(const u32x4*)(OG + (size_t)row * DM + e), b = *(const u32x4*)(OG + (size_t)(16384 + row) * DM + e), c = *(const u32x4*)(OG + (size_t)(32768 + row) * DM + e);
        const u32x4 z = *(const u32x4*)(PROJ + (size_t)row * 8192 + 7168 + e);
        u32x4 o;
#pragma unroll
        for (int j = 0; j < 4; ++j) {
            const float lo = (w0 * bf_lo(a[j]) + w1 * bf_lo(b[j]) + w2 * bf_lo(c[j])) * silu_f(bf_lo(z[j]));
            const float hi = (w0 * bf_hi(a[j]) + w1 * bf_hi(b[j]) + w2 * bf_hi(c[j])) * silu_f(bf_hi(z[j]));
            o[j] = pk_bf16(lo, hi);
        }
        *(u32x4*)(Y + (size_t)row * DM + e) = o;
    }
}

__device__ __forceinline__ bf16x8 tr_pair(const LAS unsigned char* a0, const LAS unsigned char* a1) {
    const s16x4 x = __builtin_amdgcn_ds_read_tr16_b64_v4i16((LAS s16x4*)a0), y = __builtin_amdgcn_ds_read_tr16_b64_v4i16((LAS s16x4*)a1);
    return __builtin_shufflevector(x, y, 0, 1, 2, 3, 4, 5, 6, 7);
}
__device__ __forceinline__ bf16x8 pack8(const f32x16& s, int o) {
    u32x4 w; w.x = pk_bf16(s[o + 0], s[o + 1]); w.y = pk_bf16(s[o + 2], s[o + 3]); w.z = pk_bf16(s[o + 4], s[o + 5]); w.w = pk_bf16(s[o + 6], s[o + 7]);
    return __builtin_bit_cast(bf16x8, w);
}
__device__ __forceinline__ float max3f(float a, float b, float c) { return __builtin_fmaxf(__builtin_fmaxf(a, b), c); }
__device__ __forceinline__ float max16(const f32x16& s) {
    float a = max3f(s[0], s[1], s[2]), b = max3f(s[3], s[4], s[5]); a = max3f(a, s[6], s[7]); b = max3f(b, s[8], s[9]); a = max3f(a, s[10], s[11]); b = max3f(b, s[12], s[13]);
    return max3f(a, b, __builtin_fmaxf(s[14], s[15]));
}
__device__ __forceinline__ float xmax32(float v) { const auto r = __builtin_amdgcn_permlane32_swap(__float_as_uint(v), __float_as_uint(v), false, false); return __builtin_fmaxf(__uint_as_float(r[0]), __uint_as_float(r[1])); }
__device__ __forceinline__ float xsum32(float v) { const auto r = __builtin_amdgcn_permlane32_swap(__float_as_uint(v), __float_as_uint(v), false, false); return __uint_as_float(r[0]) + __uint_as_float(r[1]); }
__device__ __forceinline__ float sum16(const f32x16& s) {
    return ((s[0] + s[1]) + (s[2] + s[3])) + ((s[4] + s[5]) + (s[6] + s[7])) + (((s[8] + s[9]) + (s[10] + s[11])) + ((s[12] + s[13]) + (s[14] + s[15])));
}

template <int HD, int DV, int HW, int MODE>
__device__ __forceinline__ void band_item(const bf16_t* __restrict__ qp, const bf16_t* __restrict__ kp, const bf16_t* __restrict__ vp, int ld, size_t tok0, int r, int L, int i0,
                                          float sink2, bf16_t* __restrict__ op, int old, float* __restrict__ lsep, const bf16_t* __restrict__ zp, LAS unsigned char* lds) {
    constexpr int CR = 128, RSK = HD * 2 + 16, RSV = DV * 2 + 64, KB = CR * RSK, NC = (256 + 2 * HW) / CR, KS = HD / 16, NTV = DV / 32;
    constexpr int KCH = HD / 8, VCH = DV / 8, KLD = KCH * CR / 512, VLD = VCH * CR / 512;
    int tid = threadIdx.x; asm volatile("" : "+v"(tid));
    const int w = __builtin_amdgcn_readfirstlane(tid >> 6), lane = tid & 63, ql = lane & 31, hh = lane >> 5;
    const int iw = i0 + 32 * w, x32a = ((lane ^ 32) << 2);
    LAS unsigned char* Kl = lds; LAS unsigned char* Vl = lds + KB;
    bf16x8 qf[KS];
    { const bf16_t* qrow = qp + (tok0 + (size_t)r * (iw + ql)) * ld + 8 * hh;
#pragma unroll
      for (int ks = 0; ks < KS; ++ks) qf[ks] = *(const bf16x8*)(qrow + 16 * ks); }
    f32x16 O[NTV];
#pragma unroll
    for (int t = 0; t < NTV; ++t)
#pragma unroll
        for (int i = 0; i < 16; ++i) O[t][i] = 0.f;
    float m = (MODE == 1) ? sink2 : -1e30f, l = (MODE == 1 && hh == 0) ? 1.0f : 0.f;
    const int pi = (ql & ~12) | ((ql & 4) << 1) | ((ql & 8) >> 1);
    const LAS unsigned char* kread = Kl + pi * RSK + 16 * hh;
    const int g16 = lane >> 4, i16 = lane & 15;
    const LAS unsigned char* vread = Vl + (8 * (g16 >> 1) + (i16 >> 2)) * RSV + (16 * (g16 & 1) + 4 * (i16 & 3)) * 2;
    u32x4 kreg[KLD], vreg[VLD];
    auto prefetch = [&](int c) {
        const int jc = i0 - HW + CR * c;
#pragma unroll
        for (int i = 0; i < KLD; ++i) { const int idx = tid + 512 * i, row = idx / KCH, ch = idx % KCH, j = jc + row;
            kreg[i] = (j >= 0 && j < L) ? *(const u32x4*)(kp + (tok0 + (size_t)r * j) * ld + ch * 8) : (u32x4){0, 0, 0, 0}; }
#pragma unroll
        for (int i = 0; i < VLD; ++i) { const int idx = tid + 512 * i, row = idx / VCH, ch = idx % VCH, j = jc + row;
            vreg[i] = (j >= 0 && j < L) ? *(const u32x4*)(vp + (tok0 + (size_t)r * j) * ld + ch * 8) : (u32x4){0, 0, 0, 0}; }
    };
    prefetch(0);
    for (int c = 0; c < NC; ++c) {
        const int jc = i0 - HW + CR * c;
        __syncthreads();
#pragma unroll
        for (int i = 0; i < KLD; ++i) { const int idx = tid + 512 * i, row = idx / KCH, ch = idx % KCH; *(LAS u32x4*)(Kl + row * RSK + ch * 16) = kreg[i]; }
#pragma unroll
        for (int i = 0; i < VLD; ++i) { const int idx = tid + 512 * i, row = idx / VCH, ch = idx % VCH; *(LAS u32x4*)(Vl + row * RSV + ch * 16) = vreg[i]; }
        __syncthreads();
        if (c + 1 < NC) prefetch(c + 1);
#pragma unroll
        for (int u = 0; u < CR / 32; ++u) {
            const int js = jc + 32 * u;
            if (js + 31 < iw - HW || js > iw + 31 + HW || js + 31 < 0 || js >= L) continue;
            f32x16 S;
#pragma unroll
            for (int i = 0; i < 16; ++i) S[i] = 0.f;
#pragma unroll
            for (int ks = 0; ks < KS; ++ks) { const bf16x8 kf = *(const LAS bf16x8*)(kread + (32 * u) * RSK + 32 * ks); S = __builtin_amdgcn_mfma_f32_32x32x16_bf16(kf, qf[ks], S, 0, 0, 0); }
            const bool full = (js >= iw + 31 - HW) && (js + 31 <= iw + HW) && js >= 0 && js + 31 < L;
            if (!full) {
                const int qi = iw + ql;
#pragma unroll
                for (int i = 0; i < 16; ++i) { const int j = js + (i & 7) + 8 * hh + 16 * (i >> 3); const int d = qi - j; const bool ok = (d <= HW) && (d >= -HW) && (j >= 0) && (j < L); S[i] = ok ? S[i] : -INFINITY; }
            }
            float mt = xmax32(max16(S));
            if (__any(mt > m + 8.0f)) {
                const float mn = fmaxf(m, mt), a = __builtin_amdgcn_exp2f(m - mn); l *= a; m = mn;
#pragma unroll
                for (int t = 0; t < NTV; ++t) O[t] = O[t] * a;
            }
#pragma unroll
            for (int i = 0; i < 16; ++i) S[i] = __builtin_amdgcn_exp2f(S[i] - m);
            l += sum16(S);
            const bf16x8 P0 = pack8(S, 0), P1 = pack8(S, 8);
#pragma unroll
            for (int t = 0; t < NTV; ++t) {
                const LAS unsigned char* vb = vread + (32 * u) * RSV + 64 * t;
                const bf16x8 v0 = tr_pair(vb, vb + 4 * RSV), v1 = tr_pair(vb + 16 * RSV, vb + 20 * RSV);
                O[t] = __builtin_amdgcn_mfma_f32_32x32x16_bf16(v0, P0, O[t], 0, 0, 0);
                O[t] = __builtin_amdgcn_mfma_f32_32x32x16_bf16(v1, P1, O[t], 0, 0, 0);
            }
        }
    }
    const float lt = xsum32(l), inv = 1.0f / lt;
    const size_t tok = tok0 + (size_t)r * (iw + ql);
    if (MODE == 0) {
        if (hh == 0) lsep[tok * 8] = m + __builtin_amdgcn_logf(lt);
#pragma unroll
        for (int t = 0; t < NTV; ++t)
#pragma unroll
            for (int i4 = 0; i4 < 4; ++i4) { u32x2 wv; wv.x = pk_bf16(O[t][4 * i4] * inv, O[t][4 * i4 + 1] * inv); wv.y = pk_bf16(O[t][4 * i4 + 2] * inv, O[t][4 * i4 + 3] * inv);
                *(u32x2*)(op + tok * old + 32 * t + 8 * i4 + 4 * hh) = wv; }
    } else {
#pragma unroll
        for (int t = 0; t < NTV; ++t)
#pragma unroll
            for (int i4 = 0; i4 < 4; ++i4) { const int dv = 32 * t + 8 * i4 + 4 * hh; const u32x2 z = *(const u32x2*)(zp + tok * ld + dv);
                u32x2 wv; wv.x = pk_bf16(O[t][4 * i4] * inv * silu_f(bf_lo(z.x)), O[t][4 * i4 + 1] * inv * silu_f(bf_hi(z.x))); wv.y = pk_bf16(O[t][4 * i4 + 2] * inv * silu_f(bf_lo(z.y)), O[t][4 * i4 + 3] * inv * silu_f(bf_hi(z.y)));
                *(u32x2*)(op + tok * old + dv) = wv; }
    }
    __syncthreads();
}

__device__ __forceinline__ void dil_attn_phase(const Params& p, int half, LAS unsigned char* lds) {
    const bf16_t* PROJ = (const bf16_t*)(p.ws + WS_PROJ); bf16_t* OG = (bf16_t*)(p.ws + WS_OG); float* LSE = (float*)(p.ws + WS_LSE);
    (void)half;
    for (int it = blockIdx.x; it < 1536; it += gridDim.x) {
        const int g = it >> 9, rem = it & 511, bl = rem >> 8, rest = rem & 255, h = rest & 7, cr = rest >> 3;
        const int r = g == 0 ? 1 : (g == 1 ? 4 : 16), L = SEQ / r, pr = cr % r, qc = cr / r;
        const size_t tok0 = (size_t)bl * SEQ + pr;
        band_item<128, 128, 64, 0>(PROJ + g * 1024 + h * 128, PROJ + 3072 + g * 1024 + h * 128, PROJ + 6144 + h * 128, 8192, tok0, r, L, qc * 256, 0.f,
                                   OG + (size_t)g * 16384 * DM + h * 128, DM, LSE + (size_t)g * 16384 * 8 + h, nullptr, lds);
    }
}
__device__ __forceinline__ void swa_attn_phase(const Params& p, LAS unsigned char* lds) {
    const bf16_t* PROJ = (const bf16_t*)(p.ws + WS_PROJ); bf16_t* Y = (bf16_t*)(p.ws + WS_H);
    for (int it = blockIdx.x; it < 2048; it += gridDim.x) {
        const int h = it & 15, rest = it >> 4, qc = rest & 31, b = rest >> 5;
        band_item<64, 64, 128, 1>(PROJ + h * 64, PROJ + 1024 + (h >> 2) * 64, PROJ + 1280 + (h >> 2) * 64, 2560, (size_t)b * SEQ, 1, SEQ, qc * 256, p.swa_sink[h] * LOG2E,
                                  Y + h * 64, DM, nullptr, PROJ + 1536 + h * 64, lds);
    }
}

__device__ __forceinline__ void knorm_phase(const Params& p) {
    const bf16_t* PROJ = (const bf16_t*)(p.ws + WS_PROJ); unsigned* KMAX = (unsigned*)(p.ws + WS_KMAX);
    const int tid = tid_opaque(), lane = tid & 63, gw = blockIdx.x * 8 + (tid >> 6);
    float mx = 0.f;
    const int row0 = gw * 16;
    if (row0 < MTOK) {
        for (int j0 = 0; j0 < 16; j0 += 8) {
            u32x4 a[8], b[8];
#pragma unroll
            for (int j = 0; j < 8; ++j) { const bf16_t* kr = PROJ + (size_t)(row0 + j0 + j) * 4096 + 1024 + 16 * lane; a[j] = *(const u32x4*)kr; b[j] = *(const u32x4*)(kr + 8); }
#pragma unroll
            for (int j = 0; j < 8; ++j) { float s = 0.f;
#pragma unroll
                for (int i = 0; i < 4; ++i) { const float x0 = bf_lo(a[j][i]), x1 = bf_hi(a[j][i]), y0 = bf_lo(b[j][i]), y1 = bf_hi(b[j][i]); s += (x0 * x0 + x1 * x1) + (y0 * y0 + y1 * y1); }
                s += swz_xor<1>(s); s += swz_xor<2>(s);
                mx = fmaxf(mx, s); }
        }
        if ((lane & 3) == 0) atomicMax(KMAX + (row0 >> 13) * 16 + (lane >> 2), __float_as_uint(mx));
    }
}

__device__ __forceinline__ int swz16(int row) { return ((row & 3) << 2) | ((row >> 2) & 3); }
__device__ __forceinline__ void diff_attn_phase(const Params& p, LAS unsigned char* lds) {
    constexpr int ld = 4096, NCH = SEQ / 64, STG = 32768;
    const bf16_t* PROJ = (const bf16_t*)(p.ws + WS_PROJ); bf16_t* Y = (bf16_t*)(p.ws + WS_H);
    int tid = threadIdx.x; asm volatile("" : "+v"(tid));
    const int w = __builtin_amdgcn_readfirstlane(tid >> 6), lane = tid & 63, ql = lane & 31, hh = lane >> 5, x32a = ((lane ^ 32) << 2);
    const int comp = w >> 2, wq = w & 3;
    const int pi = (ql & ~12) | ((ql & 4) << 1) | ((ql & 8) >> 1);
    const int swK = swz16(pi);
    const int kbase = pi * 256, kx = ((8 * comp + hh) ^ swK) << 4;
    const int g16 = lane >> 4, i16 = lane & 15, q4 = i16 >> 2, p4 = i16 & 3, cb = g16 & 1;
    const int vb0 = (8 * hh + q4) * 256 + 16 * ((2 * cb + (p4 >> 1)) ^ (2 * hh)) + 8 * (p4 & 1) + 64 * q4;
    const int vb1 = (8 * hh + 4 + q4) * 256 + 16 * ((2 * cb + (p4 >> 1)) ^ (2 * hh + 1)) + 8 * (p4 & 1) + 64 * q4;
    unsigned doff[2]; int dlds[2];
#pragma unroll
    for (int i = 0; i < 2; ++i) { const int Li = tid + 512 * i, row = Li >> 4, chp = Li & 15; doff[i] = (unsigned)(row * ld + ((chp ^ swz16(row)) << 3)) * 2u; dlds[i] = Li * 16; }
    for (int it = blockIdx.x; it < 1024; it += gridDim.x) {
        const int h = it & 7, qc = (it >> 3) & 31, b = it >> 8;
        const size_t tokb = (size_t)b * SEQ;
        const bf16_t* qp = PROJ + h * 128 + 64 * comp; const bf16_t* kp = PROJ + 1024 + h * 128; const bf16_t* vp = PROJ + 2048 + h * 128; const bf16_t* zp = PROJ + 3072 + h * 128;
        const int iw = qc * 256 + 64 * wq;
        bf16x8 qf[2][4];
        int ln0 = lane; asm volatile("" : "+v"(ln0));
#pragma unroll
        for (int r = 0; r < 2; ++r) { const bf16_t* qrow = qp + (tokb + iw + 32 * r + (ln0 & 31)) * ld + 8 * (ln0 >> 5);
#pragma unroll
            for (int ks = 0; ks < 4; ++ks) qf[r][ks] = *(const bf16x8*)(qrow + 16 * ks); }
        f32x16 O[2][4];
#pragma unroll
        for (int r = 0; r < 2; ++r)
#pragma unroll
            for (int t = 0; t < 4; ++t)
#pragma unroll
                for (int i = 0; i < 16; ++i) O[r][t][i] = 0.f;
        float m[2], l[2] = {0.f, 0.f};
        { const float kmx = __uint_as_float(((const unsigned*)(p.ws + WS_KMAX))[b * 16 + h * 2 + comp]);
#pragma unroll
          for (int r = 0; r < 2; ++r) { float s = 0.f;
#pragma unroll
              for (int ks = 0; ks < 4; ++ks) { const u32x4 qv = __builtin_bit_cast(u32x4, qf[r][ks]);
#pragma unroll
                  for (int i = 0; i < 4; ++i) { const float x0 = bf_lo(qv[i]), x1 = bf_hi(qv[i]); s += x0 * x0 + x1 * x1; } }
              m[r] = sqrtf(xsum32(s) * kmx) * 1.001f + 1e-3f; } }
        bf16x8 kone, qm[2];
        { const unsigned one = hh == 0 ? 0x3F80u : 0u; kone = __builtin_bit_cast(bf16x8, (u32x4){one, 0u, 0u, 0u});
#pragma unroll
          for (int r = 0; r < 2; ++r) { const unsigned mb = hh == 0 ? (pk_bf16(-m[r], 0.f) & 0xffffu) : 0u; qm[r] = __builtin_bit_cast(bf16x8, (u32x4){mb, 0u, 0u, 0u}); } }
        auto issue = [&](int ch, int stg) {
            const char* kg = (const char*)(kp + (tokb + 64 * ch) * ld); const char* vg = (const char*)(vp + (tokb + 64 * ch) * ld);
            LAS unsigned char* sb = lds + stg * STG;
#pragma unroll
            for (int i = 0; i < 2; ++i) { unsigned o = doff[i]; asm volatile("" : "+v"(o));
                __builtin_amdgcn_global_load_lds((const void*)(kg + o), (LAS void*)(sb + dlds[i]), 16, 0, 0);
                __builtin_amdgcn_global_load_lds((const void*)(vg + o), (LAS void*)(sb + 16384 + dlds[i]), 16, 0, 0); }
        };
        issue(0, 0); issue(1, 1);
        int s_cur = 0, s_nn = 2;
        for (int ch = 0; ch < NCH; ++ch) {
            if (ch + 1 < NCH) asm volatile("s_waitcnt vmcnt(4)" ::: "memory"); else asm volatile("s_waitcnt vmcnt(0)" ::: "memory");
            __builtin_amdgcn_s_barrier(); asm volatile("" ::: "memory");
            if (ch + 2 < NCH) issue(ch + 2, s_nn);
            const LAS unsigned char* Ksb = lds + s_cur * STG; const LAS unsigned char* Vsb = Ksb + 16384;
            s_nn = s_cur; s_cur = (s_cur == 2) ? 0 : s_cur + 1;
#pragma clang loop unroll(disable)
            for (int u = 0; u < 2; ++u) {
                const LAS unsigned char* Ku = Ksb + u * 8192; const LAS unsigned char* Vu = Vsb + u * 8192;
                int kxl = kx, vb0l = vb0, vb1l = vb1; asm volatile("" : "+v"(kxl), "+v"(vb0l), "+v"(vb1l));
                bf16x8 kf[4];
#pragma unroll
                for (int ks = 0; ks < 4; ++ks) kf[ks] = *(const LAS bf16x8*)(Ku + kbase + (kxl ^ (32 * ks)));
                bf16x8 P[2][2];
#pragma unroll
                for (int r = 0; r < 2; ++r) {
                    f32x16 S;
#pragma unroll
                    for (int i = 0; i < 16; ++i) S[i] = 0.f;
#pragma unroll
                    for (int ks = 0; ks < 4; ++ks) S = __builtin_amdgcn_mfma_f32_32x32x16_bf16(kf[ks], qf[r][ks], S, 0, 0, 0);
                    S = __builtin_amdgcn_mfma_f32_32x32x16_bf16(kone, qm[r], S, 0, 0, 0);
#pragma unroll
                    for (int i = 0; i < 16; ++i) S[i] = __builtin_amdgcn_exp2f(S[i]);
                    l[r] += sum16(S);
                    P[r][0] = pack8(S, 0); P[r][1] = pack8(S, 8);
                }
#pragma unroll
                for (int t = 0; t < 4; ++t) {
                    const LAS unsigned char* a0 = Vu + (vb0l ^ (64 * t)); const LAS unsigned char* a1 = Vu + (vb1l ^ (64 * t));
                    const bf16x8 v0 = tr_pair(a0, a1), v1 = tr_pair(a0 + 4096, a1 + 4096);
                    O[0][t] = __builtin_amdgcn_mfma_f32_32x32x16_bf16(v0, P[0][0], O[0][t], 0, 0, 0);
                    O[1][t] = __builtin_amdgcn_mfma_f32_32x32x16_bf16(v0, P[1][0], O[1][t], 0, 0, 0);
                    O[0][t] = __builtin_amdgcn_mfma_f32_32x32x16_bf16(v1, P[0][1], O[0][t], 0, 0, 0);
                    O[1][t] = __builtin_amdgcn_mfma_f32_32x32x16_bf16(v1, P[1][1], O[1][t], 0, 0, 0);
                }
            }
        }
        int lne = lane; asm volatile("" : "+v"(lne));
        const int hhe = lne >> 5, qle = lne & 31;
        float lam;
        { const float* lv = p.diff_lambda; const float a = lv[lne] * lv[64 + lne], bb = lv[128 + lne] * lv[192 + lne]; const int xa = ((lne ^ 32) << 2); lam = __expf(wave_sum(a, xa)) - __expf(wave_sum(bb, xa)) + p.lam_init; }
#pragma unroll
        for (int r = 0; r < 2; ++r) {
            __builtin_amdgcn_s_barrier(); asm volatile("" ::: "memory");
            LAS float* ex = (LAS float*)lds + wq * 4096 + lne;
            const float lt = xsum32(l[r]);
            if (comp == 1) {
                const float sc = lam / lt;
#pragma unroll
                for (int t = 0; t < 4; ++t)
#pragma unroll
                    for (int i = 0; i < 16; ++i) ex[(t * 16 + i) * 64] = O[r][t][i] * sc;
            }
            asm volatile("s_waitcnt lgkmcnt(0)" ::: "memory"); __builtin_amdgcn_s_barrier(); asm volatile("" ::: "memory");
            if (comp == 0) {
                const float i0 = 1.0f / lt; float ss = 0.f;
#pragma unroll
                for (int t = 0; t < 4; ++t)
#pragma unroll
                    for (int i = 0; i < 16; ++i) { const float a = O[r][t][i] * i0 - ex[(t * 16 + i) * 64]; O[r][t][i] = a; ss += a * a; if (i == 15) __builtin_amdgcn_sched_barrier(0); }
                ss = xsum32(ss);
                const float rn = rsqrtf(ss * (1.0f / 128.0f) + 1e-5f) * p.one_minus_lam_init;
                const unsigned tok = (unsigned)(b * SEQ + iw + 32 * r + qle), zo = tok * (unsigned)ld + 4u * hhe, yo = tok * (unsigned)DM + 4u * hhe;
#pragma unroll
                for (int t = 0; t < 4; ++t)
#pragma unroll
                    for (int i4 = 0; i4 < 4; ++i4) { const int dvc = 32 * t + 8 * i4, dv = dvc + 4 * hhe; const u32x2 z = *(const u32x2*)(zp + (zo + dvc)); const f32x4 sg = *(const f32x4*)(p.diff_subln_g + dv);
                        u32x2 wv; wv.x = pk_bf16(O[r][t][4 * i4] * rn * sg[0] * silu_f(bf_lo(z.x)), O[r][t][4 * i4 + 1] * rn * sg[1] * silu_f(bf_hi(z.x)));
                        wv.y = pk_bf16(O[r][t][4 * i4 + 2] * rn * sg[2] * silu_f(bf_lo(z.y)), O[r][t][4 * i4 + 3] * rn * sg[3] * silu_f(bf_hi(z.y)));
                        *(u32x2*)(Y + h * 128 + (yo + dvc)) = wv; if (i4 == 3) __builtin_amdgcn_sched_barrier(0); }
            }
        }
        __builtin_amdgcn_s_barrier(); asm volatile("" ::: "memory");
    }
}

#define XB_TMO      128
#define XB_XCNT(j)  (256  + 64 * (j))
#define XB_XSUB(j)  (1280 + 64 * (j))
#define XB_XGEN(j)  (2304 + 64 * (j))
#define XB_TOP      3328
#define XB_TOPGEN   3392
#define XCD_BAR_WORDS 3456
#define XB_SPIN_CAP (1u << 18)

__device__ __forceinline__ unsigned xb_ld(unsigned* p)              { return __hip_atomic_load(p, __ATOMIC_RELAXED, __HIP_MEMORY_SCOPE_AGENT); }
__device__ __forceinline__ unsigned xb_add(unsigned* p, unsigned v) { return __hip_atomic_fetch_add(p, v, __ATOMIC_RELAXED, __HIP_MEMORY_SCOPE_AGENT); }
__device__ __forceinline__ unsigned xb_xcc_id() { return (unsigned)__builtin_amdgcn_s_getreg((3 << 11) | 20) & 0xFu; }
#define XB_SPIN(cond, bar) do { unsigned _sp = 0; while (cond) { __builtin_amdgcn_s_sleep(1); \
    if ((++_sp & 255u) == 0u) { if (xb_ld(&(bar)[XB_TMO])) break; if (_sp > XB_SPIN_CAP) { atomicAdd(&(bar)[XB_TMO], 1u); break; } } } } while (0)

struct XcdBarrier {
    unsigned* bar; unsigned x;
    volatile LAS unsigned* st;
};

__device__ __forceinline__ XcdBarrier xcd_barrier_post(unsigned* bar, volatile LAS unsigned* st) {
    XcdBarrier b; b.bar = bar; b.x = xb_xcc_id(); b.st = st;
    if (threadIdx.x == 0) st[2] = xb_add(&bar[XB_XCNT(b.x)], 1u);
    return b;
}
__device__ __forceinline__ void xcd_barrier_complete(unsigned* bar, unsigned x, unsigned& nloc, unsigned& nx) {
    const unsigned G = gridDim.x * gridDim.y * gridDim.z;
    unsigned sum, cnt, mine, sp = 0u;
    for (;;) {
        sum = 0u; cnt = 0u; mine = 0u;
#pragma unroll
        for (unsigned j = 0; j < 16; ++j) { const unsigned c = xb_ld(&bar[XB_XCNT(j)]); sum += c; cnt += (c > 0u) ? 1u : 0u; mine = (j == x) ? c : mine; }
        if (sum == G) break;
        __builtin_amdgcn_s_sleep(1);
        if ((++sp & 255u) == 0u) { if (xb_ld(&bar[XB_TMO])) break; if (sp > XB_SPIN_CAP) { atomicAdd(&bar[XB_TMO], 1u); break; } }
    }
    nloc = mine > 0u ? mine : 1u; nx = cnt > 0u ? cnt : 1u;
}

__device__ __forceinline__ void xcd_barrier(const XcdBarrier& b) {
    asm volatile("s_waitcnt vmcnt(0)" ::: "memory");
    __syncthreads();
    if (threadIdx.x == 0) {
        unsigned* bar = b.bar;
        __builtin_amdgcn_s_waitcnt(0);
        unsigned nloc = b.st[0], nx = b.st[1];
        if (nloc == 0u) { xcd_barrier_complete(bar, b.x, nloc, nx); b.st[0] = nloc; b.st[1] = nx; }
        const unsigned old = xb_add(&bar[XB_XSUB(b.x)], 1u);
        const unsigned gen = old / nloc;
        if (old + 1u == (gen + 1u) * nloc) {
            __builtin_amdgcn_fence(__ATOMIC_RELEASE, "agent");
            asm volatile("s_waitcnt vmcnt(0)" ::: "memory");
            const unsigned og = xb_add(&bar[XB_TOP], 1u);
            const unsigned tg = og / nx;
            if (og + 1u == (tg + 1u) * nx) xb_add(&bar[XB_TOPGEN], 1u);
            else XB_SPIN(xb_ld(&bar[XB_TOPGEN]) == tg, bar);
            __builtin_amdgcn_fence(__ATOMIC_ACQUIRE, "agent");
            xb_add(&bar[XB_XGEN(b.x)], 1u);
            asm volatile("s_waitcnt vmcnt(0)" ::: "memory");
        } else {
            XB_SPIN(xb_ld(&bar[XB_XGEN(b.x)]) == gen, bar);
            __builtin_amdgcn_fence(__ATOMIC_ACQUIRE, "agent");
            asm volatile("s_waitcnt vmcnt(0)" ::: "memory");
        }
    }
    __syncthreads();
}


enum { K_PRO = 0, K_NORM, K_GCONV, K_CONV, K_GOUT, K_GROPE, K_ADIL, K_CDIL, K_ASWA, K_ADIFF, K_FINAL, K_KNORM };
constexpr int NPH = 23;
__constant__ int PH_KIND[NPH] = {K_PRO, K_NORM, K_GCONV, K_CONV, K_GOUT, K_NORM, K_GROPE, K_ADIL, K_CDIL, K_GROPE, K_ADIL, K_CDIL, K_GOUT, K_NORM, K_GROPE, K_ASWA, K_GOUT, K_NORM, K_GROPE, K_KNORM, K_ADIFF, K_GOUT, K_FINAL};
__constant__ int PH_LAYER[NPH] = {0, 0, 0, 0, 0, 1, 1, 1, 1, 1, 1, 1, 1, 2, 2, 2, 2, 3, 3, 3, 3, 3, 0};
__constant__ int PH_HALF[NPH] = {0, 0, 0, 0, 0, 0, 0, 0, 0, 1, 1, 1, 0, 0, 0, 0, 0, 0, 0, 0, 0, 0, 0};

__global__ void __launch_bounds__(512) mega(Params p) {
    extern __shared__ __attribute__((aligned(16))) unsigned char smem[];
    LAS unsigned char* lds = (LAS unsigned char*)smem;
    cg::grid_group grid = cg::this_grid();
    const bf16_t* WT = (const bf16_t*)(p.ws + WS_WT);
    bf16_t* H = (bf16_t*)(p.ws + WS_H); bf16_t* PROJ = (bf16_t*)(p.ws + WS_PROJ);
    const float* MOD = (const float*)(p.ws + WS_MOD);
    volatile LAS unsigned* xst = (volatile LAS unsigned*)(lds + 131072);
    if (threadIdx.x < 4) xst[threadIdx.x] = 0u;
    __syncthreads();
    const XcdBarrier xb = xcd_barrier_post((unsigned*)(p.ws + WS_BAR), xst);
    for (int ph = p.ph_lo; ph < p.ph_hi; ++ph) {
        const int kind = PH_KIND[ph], layer = PH_LAYER[ph], half = PH_HALF[ph];
        int vcu = blockIdx.x;
        { int xo = 131072; asm volatile("" : "+v"(xo));
          volatile LAS unsigned* xs = (volatile LAS unsigned*)(lds + xo);
          const unsigned nloc = xs[0], nx = xs[1], rank = xs[2]; if (nx == 8u && nloc * 8u == gridDim.x && rank < nloc) vcu = (int)(rank * 8u + xb.x); }
        vcu = __builtin_amdgcn_readfirstlane(vcu);
#ifdef DUP_MASK
        for (int rep = 0; rep < (((DUP_MASK) >> kind) & 1 ? 2 : 1); ++rep)
#endif
        switch (kind) {
        case K_PRO: prologue_phase(p, lds); break;
        case K_NORM: norm_phase(p, layer); break;
        case K_GCONV: { EpiConv e; e.out = PROJ; gm::gemm_phase(H, WT + (size_t)WR_CONV_IN * 1024, MTOK, 4096, lds, e, vcu); } break;
        case K_CONV: conv_phase(p); break;
        case K_GOUT: { EpiRes e; e.xin = layer == 0 ? p.x : p.out; e.xout = p.out; e.gate = MOD + (size_t)layer * 4 * 3072 + 2048;
            const int wr = layer == 0 ? WR_CONV_OUT : layer == 1 ? WR_DIL_OUT : layer == 2 ? WR_SWA_OUT : WR_DIFF_OUT;
            gm::gemm_phase(H, WT + (size_t)wr * 1024, MTOK, 1024, lds, e, vcu); } break;
        case K_GROPE: { EpiRope e; e.out = PROJ; int N, wr, M = MTOK; const bf16_t* A = H;
            if (layer == 1) { N = 8192; wr = WR_DIL_IN; M = 16384; A = H + (size_t)half * 16384 * DM; e.ld = 8192; e.rope_end = 6144; e.q_end = 3072; e.hd = 128; e.cosT = (const float*)(p.ws + WS_COS128); e.sinT = (const float*)(p.ws + WS_SIN128); e.qscale = 0.08838834764831845f * LOG2E; }
            else if (layer == 2) { N = 2560; wr = WR_SWA_IN; e.ld = 2560; e.rope_end = 1280; e.q_end = 1024; e.hd = 64; e.cosT = (const float*)(p.ws + WS_COS64); e.sinT = (const float*)(p.ws + WS_SIN64); e.qscale = 0.125f * LOG2E; }
            else { N = 4096; wr = WR_DIFF_IN; e.ld = 4096; e.rope_end = 2048; e.q_end = 1024; e.hd = 64; e.cosT = (const float*)(p.ws + WS_COS64); e.sinT = (const float*)(p.ws + WS_SIN64); e.qscale = 0.125f * LOG2E; }
            gm::gemm_phase(A, WT + (size_t)wr * 1024, M, N, lds, e, vcu); } break;
        case K_ADIL: dil_attn_phase(p, half, lds); break;
        case K_CDIL: dil_combine_phase(p, half); break;
        case K_ASWA: swa_attn_phase(p, lds); break;
        case K_KNORM: knorm_phase(p); break;
        case K_ADIFF: diff_attn_phase(p, lds); break;
        case K_FINAL: final_phase(p); break;
        }
        if (ph + 1 < p.ph_hi) {
            if (p.ph_lo < 0) grid.sync();
            else xcd_barrier(xb);
        }
    }
}

#ifndef N_LAUNCH_PER_PHASE
#define N_LAUNCH_PER_PHASE 0
#endif
extern "C" void kernel_launch(void* const* d_in, const int* in_sizes, int n_in, void* d_out, int out_size, void* d_ws, size_t ws_size, hipStream_t stream) {
    constexpr int LDS_BYTES = 131072 + 16;
    static int grid = 0;
    if (grid == 0) {
        if (n_in != 18 || out_size != MTOK * DM || ws_size < WS_END) { fprintf(stderr, "kernel_launch: unexpected shapes n_in %d out %d ws %zu\n", n_in, out_size, ws_size); grid = -1; return; }
        int dev = 0, cus = 0, per_cu = 0;
        hipGetDevice(&dev); hipDeviceGetAttribute(&cus, hipDeviceAttributeMultiprocessorCount, dev);
        if (hipFuncSetAttribute((const void*)mega, hipFuncAttributeMaxDynamicSharedMemorySize, LDS_BYTES) != hipSuccess) { fprintf(stderr, "hipFuncSetAttribute failed\n"); grid = -1; return; }
        hipOccupancyMaxActiveBlocksPerMultiprocessor(&per_cu, (const void*)mega, 512, LDS_BYTES);
        if (per_cu < 1) { fprintf(stderr, "occupancy query says %d blocks per CU\n", per_cu); }
        (void)hipGetLastError();
        grid = cus;
    }
    if (grid < 0) return;
    if (hipMemsetAsync(d_ws, 0, 16384, stream) != hipSuccess) { fprintf(stderr, "memset of barrier words failed\n"); return; }
    Params p{};
    p.x = (const float*)d_in[0]; p.c = (const float*)d_in[1]; p.norm_g = (const float*)d_in[2]; p.w_mod = (const float*)d_in[3]; p.b_mod = (const float*)d_in[4];
    p.conv_w_in = (const float*)d_in[5]; p.conv_k = (const float*)d_in[6]; p.conv_w_out = (const float*)d_in[7];
    p.dil_w_in = (const float*)d_in[8]; p.dil_w_out = (const float*)d_in[9];
    p.swa_w_in = (const float*)d_in[10]; p.swa_sink = (const float*)d_in[11]; p.swa_w_out = (const float*)d_in[12];
    p.diff_w_in = (const float*)d_in[13]; p.diff_lambda = (const float*)d_in[14]; p.diff_subln_g = (const float*)d_in[15]; p.diff_w_out = (const float*)d_in[16];
    p.final_g = (const float*)d_in[17];
    p.out = (float*)d_out; p.ws = (unsigned char*)d_ws;
    for (int i = 0; i < 64; ++i) p.inv128[i] = (float)std::pow(10000.0, -(double)(2 * i) / 128.0);
    for (int i = 0; i < 32; ++i) p.inv64[i] = (float)std::pow(10000.0, -(double)(2 * i) / 64.0);
    p.lam_init = (float)(0.8 - 0.6 * std::exp(-0.3 * 3.0)); p.one_minus_lam_init = 1.0f - p.lam_init;
#if N_LAUNCH_PER_PHASE
    for (int ph = 0; ph < NPH; ++ph) {
        p.ph_lo = ph; p.ph_hi = ph + 1;
        void* args[] = {&p};
        hipError_t e = hipLaunchCooperativeKernel((const void*)mega, dim3(grid), dim3(512), args, LDS_BYTES, stream);
        if (e != hipSuccess) { fprintf(stderr, "cooperative launch failed: %s (grid %d)\n", hipGetErrorString(e), grid); break; }
    }
#else
    p.ph_lo = 0; p.ph_hi = NPH;
    void* args[] = {&p};
    hipError_t e = hipLaunchCooperativeKernel((const void*)mega, dim3(grid), dim3(512), args, LDS_BYTES, stream);
    if (e != hipSuccess) fprintf(stderr, "cooperative launch failed: %s (grid %d)\n", hipGetErrorString(e), grid);
#endif
}
```
